# Optimizing an MI355X kernel written in HIP

```python
import jax, jax.numpy as jnp
from jax import lax
import numpy as np

D_MODEL = 1024
BATCH = 1
SEQ = 16384
DEPTH = 4

GRID_W = 64
CTX_LEN = 256
N_MIXERS = 3
D_FF = 2816
N_MOD = 9
NORM_EPS = 1e-6

GLA_HEADS = 4
GLA_DK = 128
GLA_DV = 256
GLA_RANK = 16
GLA_LOGIT_NORM = 16.0
GLA_CHUNK = 64
GLA_HK = GLA_HEADS * GLA_DK
GLA_HV = GLA_HEADS * GLA_DV
GLA_IN = 2 * GLA_HK + 2 * GLA_HV + 2 * GLA_RANK

D_RNN = 1536
RG_BLOCKS = 12
RG_BS = D_RNN // RG_BLOCKS
RG_CONV = 4
RG_C = 8.0

SWA_HEADS = 16
SWA_KV = 4
SWA_G = SWA_HEADS // SWA_KV
HEAD_DIM = 64
WINDOW = 128
Q_BLOCK = 128
ROT_AXIS = HEAD_DIM // 2
ROPE_BASE = 10000.0
SWA_QKV = (SWA_HEADS + 2 * SWA_KV) * HEAD_DIM

kernel_name = 'hybrid_gla_rglru_swa_macaron_dit'


def _count(m):
    return len(range(m, DEPTH, N_MIXERS))


def _rmsnorm(x, g):
    x32 = x.astype(jnp.float32)
    y = x32 * lax.rsqrt(jnp.mean(x32 * x32, axis=-1, keepdims=True) + NORM_EPS)
    return (y * g.astype(jnp.float32)).astype(x.dtype)


def _modulate(x, g, shift, scale):
    return _rmsnorm(x, g) * (1 + scale[:, None, :]) + shift[:, None, :]


def _swiglu(h, w_in, w_out):
    gate, up = jnp.split(h @ w_in, 2, axis=-1)
    return (jax.nn.silu(gate) * up) @ w_out


def _gla_states(k, v, g, s0):
    B, T, H, dk = k.shape
    n = T // GLA_CHUNK
    kc = k.reshape(B, n, GLA_CHUNK, H, dk)
    vc = v.reshape(B, n, GLA_CHUNK, H, -1)
    b = jnp.cumsum(g.reshape(B, n, GLA_CHUNK, H, dk), axis=2)
    b_last = b[:, :, -1]
    upd = jnp.einsum('bnchd,bnche->bnhde', kc * jnp.exp(b_last[:, :, None] - b), vc)
    decay = jnp.exp(b_last)

    def step(s, xs):
        dec, u = xs
        return dec[..., None] * s + u, s

    s_fin, s_before = lax.scan(step, s0, (jnp.moveaxis(decay, 1, 0), jnp.moveaxis(upd, 1, 0)))
    return jnp.moveaxis(s_before, 0, 1), s_fin, b


def _gla_output(q, k, v, b, s_before):
    B, T, H, dk = q.shape
    n = T // GLA_CHUNK
    qc = q.reshape(B, n, GLA_CHUNK, H, dk) * jnp.exp(b)
    kc = k.reshape(B, n, GLA_CHUNK, H, dk) * jnp.exp(-b)
    vc = v.reshape(B, n, GLA_CHUNK, H, -1)
    att = jnp.einsum('bnchd,bnshd->bnhcs', qc, kc)
    lower = jnp.tril(jnp.ones((GLA_CHUNK, GLA_CHUNK), dtype=bool))
    att = jnp.where(lower, att, 0.0)
    o = jnp.einsum('bnhcs,bnshe->bnche', att, vc) + jnp.einsum('bnchd,bnhde->bnche', qc, s_before)
    return o.reshape(B, T, H, -1)


def _gla_dir(q, k, v, g, s0, reverse):
    if reverse:
        q, k, v, g = (jnp.flip(t, 1) for t in (q, k, v, g))
    s_before, s_fin, b = _gla_states(k, v, g, s0)
    o = _gla_output(q, k, v, b, s_before)
    return (jnp.flip(o, 1) if reverse else o), s_fin


def _gla_mixer(h_lat, h_ctx, w_in, w_a2, b_a, norm_g, w_out, ctx_out):
    def project(h):
        B, T, _ = h.shape
        q, k, v, og, lr = jnp.split(h @ w_in, [GLA_HK, 2 * GLA_HK, 2 * GLA_HK + GLA_HV, 2 * GLA_HK + 2 * GLA_HV], axis=-1)
        q = q.reshape(B, T, GLA_HEADS, GLA_DK) * (GLA_DK ** -0.5)
        k = k.reshape(B, T, GLA_HEADS, GLA_DK)
        v = v.reshape(B, T, GLA_HEADS, GLA_DV)
        lr = lr.reshape(B, T, 2, GLA_RANK)
        logit = jnp.einsum('btzr,zrk->btzk', lr, w_a2) + b_a
        g = (jax.nn.log_sigmoid(logit.astype(jnp.float32)) / GLA_LOGIT_NORM).reshape(B, T, 2, GLA_HEADS, GLA_DK)
        return q, k, v, og, g[:, :, 0], g[:, :, 1]

    qc, kc, vc, ogc, gcf, gcb = project(h_ctx)
    q, k, v, og, gf, gb = project(h_lat)
    B = h_lat.shape[0]
    s0 = jnp.zeros((B, GLA_HEADS, GLA_DK, GLA_DV), jnp.float32)
    if ctx_out:
        oc_f, sc_f = _gla_dir(qc, kc, vc, gcf, s0, False)
        oc_b, sc_b = _gla_dir(qc, kc, vc, gcb, s0, True)
    else:
        sc_f = _gla_states(kc, vc, gcf, s0)[1]
        sc_b = _gla_states(jnp.flip(kc, 1), jnp.flip(vc, 1), jnp.flip(gcb, 1), s0)[1]
    o_f, _ = _gla_dir(q, k, v, gf, sc_f, False)
    o_b, _ = _gla_dir(q, k, v, gb, sc_b, True)

    def finish(o, gate, dtype):
        Bo, T = o.shape[:2]
        o = _rmsnorm(o, norm_g).reshape(Bo, T, GLA_HV) * jax.nn.silu(gate)
        return (o @ w_out).astype(dtype)

    y_lat = finish(o_f + o_b, og, h_lat.dtype)
    y_ctx = finish(oc_f + oc_b, ogc, h_ctx.dtype) if ctx_out else None
    return y_lat, y_ctx


def _dwconv(x, w, b):
    y = lax.conv_general_dilated(x, w[:, None, :].astype(x.dtype), window_strides=(1,), padding=[(2, 1)],
                                 dimension_numbers=('NWC', 'WIO', 'NWC'), feature_group_count=x.shape[-1])
    return y + b


def _linear_scan(a, u, h0):
    u = u.at[:, 0].add(a[:, 0] * h0)

    def comb(l, r):
        return l[0] * r[0], r[0] * l[1] + r[1]

    _, h = lax.associative_scan(comb, (a, u), axis=1)
    return h


def _rglru_mixer(h_lat, h_ctx, w_in, conv_w, conv_b, w_a, b_a, w_x, b_x, lam, w_out, ctx_out):
    def branch(h):
        B, T, _ = h.shape
        gate, xr = jnp.split(h @ w_in, 2, axis=-1)
        xr = _dwconv(xr, conv_w, conv_b)
        xb = xr.reshape(B, T, RG_BLOCKS, RG_BS)
        r = jax.nn.sigmoid(jnp.einsum('btnj,znjk->zbtnk', xb, w_a).reshape(2, B, T, D_RNN) + b_a[:, None, None])
        i = jax.nn.sigmoid(jnp.einsum('btnj,znjk->zbtnk', xb, w_x).reshape(2, B, T, D_RNN) + b_x[:, None, None])
        log_a = (-RG_C * jax.nn.softplus(-lam.astype(jnp.float32)))[:, None, None] * r.astype(jnp.float32)
        a = jnp.exp(log_a)
        u = jnp.sqrt(-jnp.expm1(2.0 * log_a)) * (i * xr[None]).astype(jnp.float32)
        return jax.nn.gelu(gate), a, u

    gc, ac, uc = branch(h_ctx)
    gl, al, ul = branch(h_lat)
    z = jnp.zeros((h_lat.shape[0], D_RNN), jnp.float32)
    hc_f = _linear_scan(ac[0], uc[0], z)
    hc_b = jnp.flip(_linear_scan(jnp.flip(ac[1], 1), jnp.flip(uc[1], 1), z), 1)
    hl_f = _linear_scan(al[0], ul[0], hc_f[:, -1])
    hl_b = jnp.flip(_linear_scan(jnp.flip(al[1], 1), jnp.flip(ul[1], 1), hc_b[:, 0]), 1)
    y_lat = (((hl_f + hl_b) * gl) @ w_out).astype(h_lat.dtype)
    y_ctx = (((hc_f + hc_b) * gc) @ w_out).astype(h_ctx.dtype) if ctx_out else None
    return y_lat, y_ctx


def _rope_2d(x, cos_r, sin_r, cos_c, sin_c):
    extra = x.ndim - 3

    def bc(t):
        return t.reshape((1, t.shape[0]) + (1,) * extra + (t.shape[1],))

    def rot(part, cos, sin):
        x1, x2 = jnp.split(part, 2, axis=-1)
        cos, sin = bc(cos), bc(sin)
        return jnp.concatenate([x1 * cos - x2 * sin, x2 * cos + x1 * sin], axis=-1)

    xr, xc = jnp.split(x.astype(jnp.float32), 2, axis=-1)
    return jnp.concatenate([rot(xr, cos_r, sin_r), rot(xc, cos_c, sin_c)], axis=-1).astype(x.dtype)


def _swa_mixer(h_lat, h_ctx, w_qkv, sink, w_out, rope, ctx_out):
    def project(h):
        B, T, _ = h.shape
        q, k, v = jnp.split(h @ w_qkv, [SWA_HEADS * HEAD_DIM, (SWA_HEADS + SWA_KV) * HEAD_DIM], axis=-1)
        return (q.reshape(B, T, SWA_KV, SWA_G, HEAD_DIM) * (HEAD_DIM ** -0.5),
                k.reshape(B, T, SWA_KV, HEAD_DIM), v.reshape(B, T, SWA_KV, HEAD_DIM))

    qc, kc, vc = project(h_ctx)
    q, k, v = project(h_lat)
    q = _rope_2d(q, *rope)
    k = _rope_2d(k, *rope)
    B, S = h_lat.shape[:2]
    n_ctx = kc.shape[1]
    nb = S // Q_BLOCK
    sink_l = sink.astype(jnp.float32).reshape(SWA_KV, SWA_G, 1, 1)

    pad = ((0, 0), (Q_BLOCK, Q_BLOCK), (0, 0), (0, 0))
    kp = jnp.pad(k, pad).reshape(B, nb + 2, Q_BLOCK, SWA_KV, HEAD_DIM)
    vp = jnp.pad(v, pad).reshape(B, nb + 2, Q_BLOCK, SWA_KV, HEAD_DIM)

    def band(t):
        return jnp.concatenate([t[:, :-2], t[:, 1:-1], t[:, 2:]], axis=2)

    qb = q.reshape(B, nb, Q_BLOCK, SWA_KV, SWA_G, HEAD_DIM)
    offs_q = jnp.arange(Q_BLOCK)
    offs_k = jnp.arange(3 * Q_BLOCK) - Q_BLOCK

    def block(args):
        n, qn, kn, vn = args
        qpos = n * Q_BLOCK + offs_q
        kpos = n * Q_BLOCK + offs_k
        valid = (kpos[None, :] >= 0) & (kpos[None, :] < S) & (jnp.abs(kpos[None, :] - qpos[:, None]) <= WINDOW)
        s_loc = jnp.where(valid, jnp.einsum('bqkgd,bskd->bkgqs', qn, kn).astype(jnp.float32), -jnp.inf)
        s_ctx = jnp.einsum('bqkgd,bckd->bkgqc', qn, kc).astype(jnp.float32)
        s_sink = jnp.broadcast_to(sink_l, (B, SWA_KV, SWA_G, Q_BLOCK, 1))
        p = jax.nn.softmax(jnp.concatenate([s_sink, s_ctx, s_loc], axis=-1), axis=-1).astype(vn.dtype)
        return (jnp.einsum('bkgqc,bckd->bqkgd', p[..., 1:1 + n_ctx], vc)
                + jnp.einsum('bkgqs,bskd->bqkgd', p[..., 1 + n_ctx:], vn))

    o = lax.map(block, (jnp.arange(nb), jnp.moveaxis(qb, 1, 0), jnp.moveaxis(band(kp), 1, 0), jnp.moveaxis(band(vp), 1, 0)))
    o = jnp.moveaxis(o, 0, 1).reshape(B, S, SWA_HEADS * HEAD_DIM)
    y_lat = (o @ w_out).astype(h_lat.dtype)
    y_ctx = None
    if ctx_out:
        s = jnp.einsum('bqkgd,bckd->bkgqc', qc, kc).astype(jnp.float32)
        s_sink = jnp.broadcast_to(sink_l, (B, SWA_KV, SWA_G, n_ctx, 1))
        p = jax.nn.softmax(jnp.concatenate([s_sink, s], axis=-1), axis=-1).astype(vc.dtype)
        oc = jnp.einsum('bkgqc,bckd->bqkgd', p[..., 1:], vc).reshape(B, n_ctx, SWA_HEADS * HEAD_DIM)
        y_ctx = (oc @ w_out).astype(h_ctx.dtype)
    return y_lat, y_ctx


def setup_inputs(seed: int = 0) -> dict:
    key = jax.random.key(seed)
    ks = iter(jax.random.split(key, 40))
    D = D_MODEL
    na, nr, ns = _count(0), _count(1), _count(2)

    def nrm(shape, s):
        return jax.random.normal(next(ks), shape, jnp.float32) * s

    a0 = jax.random.uniform(next(ks), (nr, 2, D_RNN), jnp.float32, 0.9, 0.999)
    p = a0 ** (1.0 / RG_C)
    lam = jnp.log(p) - jnp.log1p(-p)
    return {
        'x': nrm((BATCH, SEQ, D), 1.0),
        'c': nrm((BATCH, D), 1.0),
        'ctx': nrm((BATCH, CTX_LEN, D), 1.0),
        'c_ctx': nrm((D,), 1.0),
        'ada_w': nrm((DEPTH, D, N_MOD * D), 0.5 * D ** -0.5),
        'ada_b': nrm((DEPTH, N_MOD * D), 0.01),
        'norm_g': 1.0 + nrm((DEPTH, 3, D), 0.01),
        'final_g': 1.0 + nrm((D,), 0.01),
        'ffn_w_in': nrm((DEPTH, 2, D, 2 * D_FF), D ** -0.5),
        'ffn_w_out': nrm((DEPTH, 2, D_FF, D), D_FF ** -0.5),
        'gla_w_in': nrm((na, D, GLA_IN), D ** -0.5),
        'gla_w_a2': nrm((na, 2, GLA_RANK, GLA_HK), GLA_RANK ** -0.5),
        'gla_b_a': nrm((na, 2, GLA_HK), 0.01),
        'gla_norm_g': 1.0 + nrm((na, GLA_DV), 0.01),
        'gla_w_out': nrm((na, GLA_HV, D), GLA_HV ** -0.5),
        'rg_w_in': nrm((nr, D, 2 * D_RNN), D ** -0.5),
        'rg_conv_w': nrm((nr, RG_CONV, D_RNN), RG_CONV ** -0.5),
        'rg_conv_b': nrm((nr, D_RNN), 0.01),
        'rg_w_a': nrm((nr, 2, RG_BLOCKS, RG_BS, RG_BS), RG_BS ** -0.5),
        'rg_b_a': nrm((nr, 2, D_RNN), 0.01),
        'rg_w_x': nrm((nr, 2, RG_BLOCKS, RG_BS, RG_BS), RG_BS ** -0.5),
        'rg_b_x': nrm((nr, 2, D_RNN), 0.01),
        'rg_lam': lam,
        'rg_w_out': nrm((nr, D_RNN, D), D_RNN ** -0.5),
        'swa_w_qkv': nrm((ns, D, SWA_QKV), D ** -0.5),
        'swa_sink': nrm((ns, SWA_HEADS), 1.0),
        'swa_w_out': nrm((ns, SWA_HEADS * HEAD_DIM, D), (SWA_HEADS * HEAD_DIM) ** -0.5),
    }


def reference(x, c, ctx, c_ctx, ada_w, ada_b, norm_g, final_g, ffn_w_in, ffn_w_out,
              gla_w_in, gla_w_a2, gla_b_a, gla_norm_g, gla_w_out,
              rg_w_in, rg_conv_w, rg_conv_b, rg_w_a, rg_b_a, rg_w_x, rg_b_x, rg_lam, rg_w_out,
              swa_w_qkv, swa_sink, swa_w_out):
    B, S, D = x.shape
    rows = S // GRID_W
    row_ids = jnp.repeat(jnp.arange(rows), GRID_W).astype(jnp.float32)
    col_ids = jnp.tile(jnp.arange(GRID_W), rows).astype(jnp.float32)
    freqs = ROPE_BASE ** (-jnp.arange(0, ROT_AXIS, 2, dtype=jnp.float32) / ROT_AXIS)
    ang_r = row_ids[:, None] * freqs
    ang_c = col_ids[:, None] * freqs
    rope = (jnp.cos(ang_r), jnp.sin(ang_r), jnp.cos(ang_c), jnp.sin(ang_c))

    xc = ctx
    act_lat = jax.nn.silu(c)
    act_ctx = jax.nn.silu(c_ctx)[None]
    for i in range(DEPTH):
        m, j = i % N_MIXERS, i // N_MIXERS
        last = i == DEPTH - 1
        ml = jnp.split(act_lat @ ada_w[i] + ada_b[i], N_MOD, axis=-1)
        mc = jnp.split(act_ctx @ ada_w[i] + ada_b[i], N_MOD, axis=-1)
        x = x + 0.5 * ml[2][:, None] * _swiglu(_modulate(x, norm_g[i, 0], ml[0], ml[1]), ffn_w_in[i, 0], ffn_w_out[i, 0])
        xc = xc + 0.5 * mc[2][:, None] * _swiglu(_modulate(xc, norm_g[i, 0], mc[0], mc[1]), ffn_w_in[i, 0], ffn_w_out[i, 0])
        h_l = _modulate(x, norm_g[i, 1], ml[3], ml[4])
        h_c = _modulate(xc, norm_g[i, 1], mc[3], mc[4])
        if m == 0:
            y_l, y_c = _gla_mixer(h_l, h_c, gla_w_in[j], gla_w_a2[j], gla_b_a[j], gla_norm_g[j], gla_w_out[j], not last)
        elif m == 1:
            y_l, y_c = _rglru_mixer(h_l, h_c, rg_w_in[j], rg_conv_w[j], rg_conv_b[j], rg_w_a[j], rg_b_a[j],
                                    rg_w_x[j], rg_b_x[j], rg_lam[j], rg_w_out[j], not last)
        else:
            y_l, y_c = _swa_mixer(h_l, h_c, swa_w_qkv[j], swa_sink[j], swa_w_out[j], rope, not last)
        x = x + ml[5][:, None] * y_l
        x = x + 0.5 * ml[8][:, None] * _swiglu(_modulate(x, norm_g[i, 2], ml[6], ml[7]), ffn_w_in[i, 1], ffn_w_out[i, 1])
        if not last:
            xc = xc + mc[5][:, None] * y_c
            xc = xc + 0.5 * mc[8][:, None] * _swiglu(_modulate(xc, norm_g[i, 2], mc[6], mc[7]), ffn_w_in[i, 1], ffn_w_out[i, 1])
    return _rmsnorm(x, final_g)
```

```cpp
#include <hip/hip_runtime.h>
#include <hip/hip_cooperative_groups.h>
#include <cstdio>
#include <cstdint>
namespace cg = cooperative_groups;
namespace pg8 {
#define PG8_LAS __attribute__((address_space(3)))
typedef unsigned short bf16_t;
typedef short bf16x8 __attribute__((ext_vector_type(8)));
typedef float f32x4 __attribute__((ext_vector_type(4)));
typedef unsigned u32x4 __attribute__((ext_vector_type(4)));
constexpr int BM = 256, BK = 64, HALF = 128, HTB = HALF * BK * 2  , STAGE_BYTES = 8 * HTB, NXCD = 8, WGM = 8;

__host__ __device__ __forceinline__ int lds_byte(int r, int c) { const int st = (r >> 4) * 2 + (c >> 5), rr = r & 15, cc = c & 31, ob = rr * 64 + cc * 2; return st * 1024 + (ob ^ (((ob >> 9) & 1) << 5)); }
__host__ __device__ __forceinline__ void stage_rc(int b, int& R, int& C) { const int st = b / 1024, sb = b % 1024, swz = sb ^ (((sb >> 9) & 1) << 5); R = (st >> 1) * 16 + swz / 64; C = (st & 1) * 32 + (swz % 64) / 2; }
__host__ __device__ __forceinline__ int perm32(int rho) { const int n = rho >> 4, i = rho & 15; return 8 * (i >> 2) + 4 * n + (i & 3); }

struct Unit { int pm, pn, ks; };
struct Gemm { const bf16_t* A; const bf16_t* Bt; int M, N, K, KS; };

struct StaticOrder {
    int nM, nN, nwg, G, c;
    __host__ __device__ void init(int M, int N, int G_, int c_) { nM = M / BM; nN = N / BM; nwg = nM * nN; G = G_; c = c_; }
    __host__ __device__ bool next(int i, Unit& u) const {
        const long L = (long)i * G + c; if (L >= nwg) return false;
        int wgid = (int)L; { const int q = nwg / NXCD, r = nwg % NXCD, xcd = wgid % NXCD, off = wgid / NXCD; wgid = (xcd < r ? xcd * (q + 1) : r * (q + 1) + (xcd - r) * q) + off; }
        const int nig = WGM * nN, gid = wgid / nig, fm = gid * WGM, gsz = (nM - fm) < WGM ? (nM - fm) : WGM;
        u.pm = fm + ((wgid % nig) % gsz); u.pn = (wgid % nig) / gsz; u.ks = 0; return true;
    }
    __device__ __forceinline__ void a_ready(const Unit&) const {}
    __device__ __forceinline__ void done(const Unit&) const {}
};
struct SplitKOrder {
    int pm, nN, nks, G, c;
    __host__ __device__ bool next(int i, Unit& u) const { const int L = i * G + c; if (L >= nN * nks) return false; u.pm = pm; u.pn = L % nN; u.ks = L / nN; return true; }
    __device__ __forceinline__ void a_ready(const Unit&) const {}
    __device__ __forceinline__ void done(const Unit&) const {}
};
__device__ __forceinline__ unsigned cvt_pk_bf16(float lo, float hi) { unsigned r; asm volatile("v_cvt_pk_bf16_f32 %0, %1, %2" : "=v"(r) : "v"(lo), "v"(hi)); return r; }
template <class Epi, class Sched, bool ALIGN_EPI = false, bool SP2 = false>
__device__ __forceinline__ void gemm_phase(PG8_LAS unsigned char* lds, const Gemm g, const Sched& S, const Epi& E, const int tid_in) {
    const int tid = tid_in, wid = __builtin_amdgcn_readfirstlane(tid >> 6), lane = tid & 63, wr = wid >> 2, wc = wid & 3, fr = lane & 15, fq = lane >> 4;
    const int K = g.K, nt = g.KS / BK; const size_t ksb = (size_t)g.KS * 2;
    unsigned voffA[2], voffB[2];
#pragma unroll
    for (int i = 0; i < 2; ++i) { int R, C; stage_rc(tid * 16 + i * 8192, R, C); const int Rb = Epi::PERM ? ((R & ~31) + perm32(R & 31)) : R;
        voffA[i] = (unsigned)(R * K + C) * 2u; voffB[i] = (unsigned)(Rb * K + C) * 2u; }
    const size_t kstep = (size_t)(BK * 2);
    const size_t hstep = (size_t)HALF * K * 2;
    const size_t tstep = 2 * hstep;
    const unsigned ldsw = (unsigned)wid * 1024u;
    const int aoff = lds_byte(wr * 64 + fr, fq * 8), boff = lds_byte(wc * 32 + fr, fq * 8);
#define PG8_SA(b, h) (((b) * 2 + (h)) * HTB)
#define PG8_SB(b, h) ((4 + (b) * 2 + (h)) * HTB)
#define PG8_STAGE(bufoff, gbase, voff) do { _Pragma("unroll") for (int _i = 0; _i < 2; ++_i) \
        __builtin_amdgcn_global_load_lds((const unsigned*)((const char*)(gbase) + (voff)[_i]), (PG8_LAS unsigned*)(lds + (bufoff) + ldsw + _i * 8192), 16, 0, 0); } while (0)
#define PG8_LDA(dst, b, h) do { _Pragma("unroll") for (int m = 0; m < 4; ++m) _Pragma("unroll") for (int k = 0; k < 2; ++k) dst[m][k] = *(const PG8_LAS bf16x8*)(lds + PG8_SA(b, h) + aoff + m * 2048 + k * 1024); } while (0)
#define PG8_LDB(dst, b, h) do { _Pragma("unroll") for (int n = 0; n < 2; ++n) _Pragma("unroll") for (int k = 0; k < 2; ++k) dst[n][k] = *(const PG8_LAS bf16x8*)(lds + PG8_SB(b, h) + boff + n * 2048 + k * 1024); } while (0)
#define PG8_MMA(ai, bj, At, Bt) do { __builtin_amdgcn_s_setprio(1); _Pragma("unroll") for (int m = 0; m < 4; ++m) _Pragma("unroll") for (int n = 0; n < 2; ++n) _Pragma("unroll") for (int k = 0; k < 2; ++k) \
        acc[ai][bj][m][n] = __builtin_amdgcn_mfma_f32_16x16x32_bf16(Bt[n][k], At[m][k], acc[ai][bj][m][n], 0, 0, 0); __builtin_amdgcn_s_setprio(0); } while (0)
#define PG8_WAIT_V(n) asm volatile("s_waitcnt vmcnt(" #n ")" ::: "memory")
#define PG8_WAIT_L(n) asm volatile("s_waitcnt lgkmcnt(" #n ")" ::: "memory")
#define PG8_BAR __builtin_amdgcn_s_barrier()
#define PG8_SCHED __builtin_amdgcn_sched_barrier(0)
    Unit cur, nxt; int ui = 0;
    if (!S.next(0, cur)) return;
    f32x4 acc[2][2][4][2];
#pragma unroll
    for (int a = 0; a < 2; ++a)
#pragma unroll
        for (int b = 0; b < 2; ++b)
#pragma unroll
            for (int m = 0; m < 4; ++m)
#pragma unroll
                for (int n = 0; n < 2; ++n) acc[a][b][m][n] = (f32x4){0.f, 0.f, 0.f, 0.f};
    bf16x8 At[4][2], B0[2][2], B1[2][2];
    const char* cA = (const char*)g.A + (size_t)cur.pm * tstep + (size_t)cur.ks * ksb; const char* cB = (const char*)g.Bt + (size_t)cur.pn * tstep + (size_t)cur.ks * ksb;
    S.a_ready(cur);
    if constexpr (SP2) {
        PG8_STAGE(PG8_SB(0, 0), cB, voffB); PG8_STAGE(PG8_SB(0, 1), cB + hstep, voffB); PG8_STAGE(PG8_SA(0, 0), cA, voffA); PG8_STAGE(PG8_SA(0, 1), cA + hstep, voffA);
        if (wr == 1) PG8_BAR;
        PG8_WAIT_V(2); PG8_BAR;
        PG8_STAGE(PG8_SB(1, 0), cB + kstep, voffB); PG8_STAGE(PG8_SA(1, 0), cA + kstep, voffA); PG8_STAGE(PG8_SB(1, 1), cB + hstep + kstep, voffB);
        PG8_WAIT_V(6); PG8_BAR;
    } else {
        PG8_STAGE(PG8_SB(0, 0), cB, voffB); PG8_STAGE(PG8_SA(0, 0), cA, voffA); PG8_STAGE(PG8_SB(0, 1), cB + hstep, voffB); PG8_STAGE(PG8_SA(0, 1), cA + hstep, voffA);
        if (wr == 1) PG8_BAR;
        PG8_WAIT_V(4); PG8_BAR;
        PG8_STAGE(PG8_SB(1, 0), cB + kstep, voffB); PG8_STAGE(PG8_SA(1, 0), cA + kstep, voffA); PG8_STAGE(PG8_SB(1, 1), cB + hstep + kstep, voffB);
        PG8_WAIT_V(6); PG8_BAR;
    }
    for (;;) {
        const bool has_next = S.next(ui + 1, nxt);
        const char* nA = has_next ? (const char*)g.A + (size_t)nxt.pm * tstep + (size_t)nxt.ks * ksb : cA; const char* nB = has_next ? (const char*)g.Bt + (size_t)nxt.pn * tstep + (size_t)nxt.ks * ksb : cB;
        for (int t = 0; t < nt; t += 2) {
            const bool last = (t == nt - 2);
            const char* a1 = cA + (size_t)(t + 1) * kstep;
            const char* a2 = last ? nA : cA + (size_t)(t + 2) * kstep; const char* b2 = last ? nB : cB + (size_t)(t + 2) * kstep;
            const char* a3 = a2 + kstep; const char* b3 = b2 + kstep;
            if (last && has_next) S.a_ready(nxt);
            if constexpr (SP2) {
            PG8_LDB(B0, 0, 0); PG8_LDB(B1, 0, 1); PG8_SCHED; PG8_LDA(At, 0, 0); PG8_STAGE(PG8_SA(1, 1), a1 + hstep, voffA);
            PG8_WAIT_V(8); PG8_WAIT_L(0); PG8_BAR; PG8_MMA(0, 0, At, B0); PG8_MMA(0, 1, At, B1); PG8_BAR; PG8_SCHED;
            PG8_LDA(At, 0, 1); PG8_STAGE(PG8_SB(0, 0), b2, voffB); PG8_STAGE(PG8_SB(0, 1), b2 + hstep, voffB); PG8_STAGE(PG8_SA(0, 0), a2, voffA);
            PG8_WAIT_V(8); PG8_WAIT_L(0); PG8_BAR; PG8_MMA(1, 0, At, B0); PG8_MMA(1, 1, At, B1); PG8_BAR; PG8_SCHED;
            PG8_LDB(B0, 1, 0); PG8_LDB(B1, 1, 1); PG8_SCHED; PG8_LDA(At, 1, 0); PG8_STAGE(PG8_SA(0, 1), a2 + hstep, voffA);
            PG8_WAIT_V(8); PG8_WAIT_L(0); PG8_BAR; PG8_MMA(0, 0, At, B0); PG8_MMA(0, 1, At, B1); PG8_BAR; PG8_SCHED;
            PG8_LDA(At, 1, 1); PG8_STAGE(PG8_SB(1, 0), b3, voffB); PG8_STAGE(PG8_SB(1, 1), b3 + hstep, voffB); PG8_STAGE(PG8_SA(1, 0), a3, voffA);
            PG8_WAIT_V(8); PG8_WAIT_L(0); PG8_BAR; PG8_MMA(1, 0, At, B0); PG8_MMA(1, 1, At, B1); PG8_BAR; PG8_SCHED;
            } else {
            PG8_LDB(B0, 0, 0); PG8_SCHED; PG8_LDA(At, 0, 0); PG8_STAGE(PG8_SA(1, 1), a1 + hstep, voffA);
            PG8_WAIT_L(8); PG8_BAR; PG8_WAIT_L(0); PG8_MMA(0, 0, At, B0); PG8_BAR; PG8_SCHED;
            PG8_LDB(B1, 0, 1); PG8_STAGE(PG8_SB(0, 0), b2, voffB);
            PG8_BAR; PG8_WAIT_L(0); PG8_MMA(0, 1, At, B1); PG8_BAR;
            PG8_LDA(At, 0, 1); PG8_STAGE(PG8_SA(0, 0), a2, voffA);
            PG8_BAR; PG8_WAIT_L(0); PG8_MMA(1, 0, At, B0); PG8_BAR; PG8_SCHED;
            PG8_STAGE(PG8_SB(0, 1), b2 + hstep, voffB);
            PG8_WAIT_V(6); PG8_BAR; PG8_MMA(1, 1, At, B1); PG8_BAR;
            PG8_LDB(B0, 1, 0); PG8_SCHED; PG8_LDA(At, 1, 0); PG8_STAGE(PG8_SA(0, 1), a2 + hstep, voffA);
            PG8_WAIT_L(8); PG8_BAR; PG8_WAIT_L(0); PG8_MMA(0, 0, At, B0); PG8_BAR; PG8_SCHED;
            PG8_LDB(B1, 1, 1); PG8_STAGE(PG8_SB(1, 0), b3, voffB);
            PG8_BAR; PG8_WAIT_L(0); PG8_MMA(0, 1, At, B1); PG8_BAR;
            PG8_LDA(At, 1, 1); PG8_STAGE(PG8_SA(1, 0), a3, voffA);
            PG8_BAR; PG8_WAIT_L(0); PG8_MMA(1, 0, At, B0); PG8_BAR; PG8_SCHED;
            PG8_STAGE(PG8_SB(1, 1), b3 + hstep, voffB);
            PG8_WAIT_V(6); PG8_BAR; PG8_MMA(1, 1, At, B1); PG8_BAR;
            }
        }
        if constexpr (ALIGN_EPI) { if (wr == 0) PG8_BAR; }
        if constexpr (!Epi::AFTER_DRAIN) { E(acc, cur, wr, wc, fr, fq); S.done(cur); }
        if (!has_next) break;
#pragma unroll
        for (int a = 0; a < 2; ++a)
#pragma unroll
            for (int b = 0; b < 2; ++b)
#pragma unroll
                for (int m = 0; m < 4; ++m)
#pragma unroll
                    for (int n = 0; n < 2; ++n) acc[a][b][m][n] = (f32x4){0.f, 0.f, 0.f, 0.f};
        cur = nxt; cA = nA; cB = nB; ++ui;
        if constexpr (ALIGN_EPI) { if (wr == 1) PG8_BAR; }
    }
    PG8_WAIT_V(0);
    if constexpr (!ALIGN_EPI) { if (wr == 0) PG8_BAR; }
    PG8_BAR;
    if constexpr (Epi::AFTER_DRAIN) { E.fused(acc, cur, wr, wc, fr, fq, lds, wid, lane); S.done(cur); }
#undef PG8_SA
#undef PG8_SB
#undef PG8_STAGE
#undef PG8_LDA
#undef PG8_LDB
#undef PG8_MMA
#undef PG8_WAIT_V
#undef PG8_WAIT_L
#undef PG8_BAR
#undef PG8_SCHED
}
}

#define LAS __attribute__((address_space(3)))
typedef unsigned short bf16;
typedef short bf16x8 __attribute__((ext_vector_type(8)));
typedef short bf16x4 __attribute__((ext_vector_type(4)));
typedef float f32x4 __attribute__((ext_vector_type(4)));
typedef float f32x2 __attribute__((ext_vector_type(2)));
typedef unsigned u32x4 __attribute__((ext_vector_type(4)));
typedef unsigned u32x2 __attribute__((ext_vector_type(2)));

constexpr int D = 1024, SEQ = 16384, CTXL = 256, MT = SEQ + CTXL, DFF = 2816, NMODV = 9 * 1024, DEPTH = 4;
constexpr int NCH = MT / 64;
constexpr int GLA_NP = 3328;
constexpr float NORM_EPS = 1e-6f;
constexpr size_t MiB = 1u << 20;
constexpr size_t WS_MOD = 0, WS_ROPE = 1 * MiB, WS_WFI = 2 * MiB, WS_WFO = 90 * MiB, WS_WGI = 134 * MiB, WS_WGO = 147 * MiB, WS_WRI = 151 * MiB, WS_WRO = 157 * MiB,
                 WS_WRA = 160 * MiB, WS_WRX = 161 * MiB, WS_WSQ = 162 * MiB, WS_WSO = 165 * MiB, WS_X = 168 * MiB, WS_XN = 233 * MiB, WS_OB = 266 * MiB, WS_AR = 315 * MiB, WS_SLAB = 622 * MiB, WS_END = 634 * MiB;
constexpr size_t A_H = 0;
constexpr size_t A_P = 0, A_LR = 98 * MiB, A_QD = 101 * MiB, A_KN = 134 * MiB, A_DEC = 167 * MiB, A_US = 169 * MiB;
constexpr size_t A_GG = 0, A_XR = 49 * MiB, A_AP = 98 * MiB, A_HE = 102 * MiB, A_CIN = 106 * MiB, A_LA = 110 * MiB, A_UU = 208 * MiB;
constexpr size_t A_QKV = 0;
#ifndef DUP_MASK
#define DUP_MASK 0
#endif
constexpr int LDS_BYTES = 135168;
constexpr int LDS_MISC = 135168 - 64;
constexpr size_t WS_BAR = 640 * 1024, BAR_BYTES = 16384;
#ifndef PH_LIMIT
#define PH_LIMIT (1 << 20)
#endif

struct Args { const float* in[27]; float* out; unsigned char* ws; int ph_lo, ph_hi; };

struct Fr {
    LAS unsigned char* lds; int tid, lane, wave, G, bx;
    const float *x, *c, *ctx, *c_ctx, *ada_w, *ada_b, *norm_g, *final_g, *ffn_w_in, *ffn_w_out, *gla_w_in, *gla_w_a2, *gla_b_a, *gla_norm_g, *gla_w_out,
        *rg_w_in, *rg_conv_w, *rg_conv_b, *rg_w_a, *rg_b_a, *rg_w_x, *rg_b_x, *rg_lam, *rg_w_out, *swa_w_qkv, *swa_sink, *swa_w_out;
    float* out; unsigned char* ws;
    float *MOD, *ROPE, *X; bf16 *WFI, *WFO, *WGI, *WGO, *WRI, *WRO, *WRA, *WRX, *WSQ, *WSO, *XN, *OB, *H;
    bf16 *P, *QD, *KN, *US; float *LR, *DEC;
    bf16 *GG, *XR, *LAg, *UUg; float *AP, *HE, *CIN;
    bf16* QKV; float* SLAB;
};

typedef __bf16 bf16x2_t __attribute__((ext_vector_type(2)));
__device__ __forceinline__ unsigned pk2(float lo, float hi) { f32x2 v = {lo, hi}; bf16x2_t b = __builtin_convertvector(v, bf16x2_t); return __builtin_bit_cast(unsigned, b); }
__device__ __forceinline__ float bf2f(unsigned short b) { return __uint_as_float(((unsigned)b) << 16); }
__device__ __forceinline__ float bflo(unsigned u) { return __uint_as_float(u << 16); }
__device__ __forceinline__ float bfhi(unsigned u) { return __uint_as_float(u & 0xffff0000u); }
__device__ __forceinline__ unsigned short f2bf1(float f) { return (unsigned short)(pk2(f, 0.f) & 0xffffu); }
__device__ __forceinline__ float shx(float v, int o, int lane) { return __builtin_bit_cast(float, __builtin_amdgcn_ds_bpermute((lane ^ o) << 2, __builtin_bit_cast(int, v))); }
__device__ __forceinline__ float wave_sum(float v, int lane) {
#pragma unroll
    for (int o = 1; o < 64; o <<= 1) v += shx(v, o, lane);
    return v;
}
__device__ __forceinline__ f32x4 mma(bf16x8 a, bf16x8 b, f32x4 c) { return __builtin_amdgcn_mfma_f32_16x16x32_bf16(a, b, c, 0, 0, 0); }
__device__ __forceinline__ float sigmoidf_(float x) { return __builtin_amdgcn_rcpf(1.0f + __expf(-x)); }
__device__ __forceinline__ float siluf_(float x) { return x * sigmoidf_(x); }
__device__ __forceinline__ float gelu_tanh_(float x) { const float y = 0.7978845608028654f * (x + 0.044715f * x * x * x); return x * sigmoidf_(2.0f * y); }
__device__ __forceinline__ float logsigmoid_(float x) { return fminf(x, 0.f) - __logf(1.0f + __expf(-fabsf(x))); }
__device__ __forceinline__ float softplus_(float x) { return fmaxf(x, 0.f) + __logf(1.0f + __expf(-fabsf(x))); }
#define LDS_WAIT() asm volatile("s_waitcnt lgkmcnt(0)" ::: "memory")

using pg8::Unit;
struct EpiSwiglu {
    static constexpr bool PERM = true, AFTER_DRAIN = false;
    bf16* H;
    __device__ __forceinline__ void operator()(const f32x4 (&acc)[2][2][4][2], const Unit& u, int wr, int wc, int fr, int fq) const {
        int z0 = 0; asm volatile("" : "+v"(z0));
        const int row0 = u.pm * 256 + wr * 64 + fr + z0, col0 = u.pn * 128 + wc * 32 + 8 * fq;
#pragma unroll
        for (int ai = 0; ai < 2; ++ai)
#pragma unroll
            for (int m = 0; m < 4; ++m) {
                bf16* rowp = H + (size_t)(row0 + ai * 128 + m * 16) * DFF + col0;
                const f32x4 g0 = acc[ai][0][m][0], g1 = acc[ai][0][m][1], u0 = acc[ai][1][m][0], u1 = acc[ai][1][m][1];
                u32x4 w;
                w.x = pk2(siluf_(g0[0]) * u0[0], siluf_(g0[1]) * u0[1]); w.y = pk2(siluf_(g0[2]) * u0[2], siluf_(g0[3]) * u0[3]);
                w.z = pk2(siluf_(g1[0]) * u1[0], siluf_(g1[1]) * u1[1]); w.w = pk2(siluf_(g1[2]) * u1[2], siluf_(g1[3]) * u1[3]);
                *(u32x4*)rowp = w;
            }
    }
};
struct EpiResid {
    static constexpr bool PERM = false, AFTER_DRAIN = false;
    float* X; const float* modl; int gidx; float coef;
    __device__ __forceinline__ void operator()(const f32x4 (&acc)[2][2][4][2], const Unit& u, int wr, int wc, int fr, int fq) const {
        const float* gp = modl + (u.pm == 64 ? NMODV : 0) + gidx * 1024;
        int z0 = 0; asm volatile("" : "+v"(z0));
        const int row0 = u.pm * 256 + wr * 64 + fr + z0, col0 = u.pn * 256 + wc * 32 + 4 * fq;
#pragma unroll
        for (int bj = 0; bj < 2; ++bj)
#pragma unroll
            for (int n = 0; n < 2; ++n) {
                const int col = col0 + bj * 128 + n * 16;
                const f32x4 gv = *(const f32x4*)(gp + col) * coef;
#pragma unroll
                for (int ai = 0; ai < 2; ++ai)
#pragma unroll
                    for (int m = 0; m < 4; ++m) {
                        float* p = X + (size_t)(row0 + ai * 128 + m * 16) * D + col;
                        f32x4 v = *(const f32x4*)p; v += gv * acc[ai][bj][m][n]; *(f32x4*)p = v;
                    }
            }
    }
};
struct EpiGlaIn {
    static constexpr bool PERM = true, AFTER_DRAIN = false;
    bf16* P; float* LR;
    __device__ __forceinline__ void operator()(const f32x4 (&acc)[2][2][4][2], const Unit& u, int wr, int wc, int fr, int fq) const {
        int z0 = 0; asm volatile("" : "+v"(z0));
        const int row0 = u.pm * 256 + wr * 64 + fr + z0;
        if (u.pn < 12) {
            const float sc = (u.pn < 2) ? 0.08838834764831845f : 1.0f;
            const int col0 = u.pn * 256 + wc * 32 + 8 * fq;
#pragma unroll
            for (int ai = 0; ai < 2; ++ai)
#pragma unroll
                for (int m = 0; m < 4; ++m)
#pragma unroll
                    for (int bj = 0; bj < 2; ++bj) {
                        const f32x4 v0 = acc[ai][bj][m][0] * sc, v1 = acc[ai][bj][m][1] * sc;
                        u32x4 w; w.x = pk2(v0[0], v0[1]); w.y = pk2(v0[2], v0[3]); w.z = pk2(v1[0], v1[1]); w.w = pk2(v1[2], v1[3]);
                        *(u32x4*)(P + (size_t)(row0 + ai * 128 + m * 16) * 3072 + col0 + bj * 128) = w;
                    }
        } else if (wc == 0) {
#pragma unroll
            for (int ai = 0; ai < 2; ++ai)
#pragma unroll
                for (int m = 0; m < 4; ++m) {
                    float* p = LR + (size_t)(row0 + ai * 128 + m * 16) * 32 + 8 * fq;
                    *(f32x4*)p = acc[ai][0][m][0]; *(f32x4*)(p + 4) = acc[ai][0][m][1];
                }
        }
    }
};
struct EpiRgIn {
    static constexpr bool PERM = true, AFTER_DRAIN = false;
    bf16* GG; bf16* XR;
    __device__ __forceinline__ void operator()(const f32x4 (&acc)[2][2][4][2], const Unit& u, int wr, int wc, int fr, int fq) const {
        int z0 = 0; asm volatile("" : "+v"(z0));
        const int row0 = u.pm * 256 + wr * 64 + fr + z0;
        const bool isg = u.pn < 6;
        bf16* base = isg ? GG : XR;
        const int col0 = (isg ? u.pn : u.pn - 6) * 256 + wc * 32 + 8 * fq;
#pragma unroll
        for (int ai = 0; ai < 2; ++ai)
#pragma unroll
            for (int m = 0; m < 4; ++m)
#pragma unroll
                for (int bj = 0; bj < 2; ++bj) {
                    f32x4 v0 = acc[ai][bj][m][0], v1 = acc[ai][bj][m][1];
                    if (isg) {
#pragma unroll
                        for (int e = 0; e < 4; ++e) { v0[e] = gelu_tanh_(v0[e]); v1[e] = gelu_tanh_(v1[e]); }
                    }
                    u32x4 w; w.x = pk2(v0[0], v0[1]); w.y = pk2(v0[2], v0[3]); w.z = pk2(v1[0], v1[1]); w.w = pk2(v1[2], v1[3]);
                    *(u32x4*)(base + (size_t)(row0 + ai * 128 + m * 16) * 1536 + col0 + bj * 128) = w;
                }
    }
};
struct EpiSwaQkv {
    static constexpr bool PERM = false, AFTER_DRAIN = false;
    bf16* QKV; const float* rope;
    __device__ __forceinline__ void operator()(const f32x4 (&acc)[2][2][4][2], const Unit& u, int wr, int wc, int fr, int fq) const {
        int z0 = 0; asm volatile("" : "+v"(z0));
        const int row0 = u.pm * 256 + wr * 64 + fr + z0;
        const float sc = (u.pn < 4) ? 0.125f : 1.0f;
        const bool do_rope = (u.pn < 5) && (u.pm < 64);
        const int col0 = u.pn * 256 + wc * 32 + 4 * fq;
#pragma unroll
        for (int ai = 0; ai < 2; ++ai)
#pragma unroll
            for (int m = 0; m < 4; ++m) {
                const int row = row0 + ai * 128 + m * 16;
                f32x4 cs0 = {1.f, 0.f, 1.f, 0.f}, cs1 = {1.f, 0.f, 1.f, 0.f};
                if (do_rope) { const int id = (wc & 1) ? (row & 63) : (row >> 6); const float* tp = rope + (size_t)(id * 16 + 4 * fq) * 2; cs0 = *(const f32x4*)tp; cs1 = *(const f32x4*)(tp + 4); }
#pragma unroll
                for (int bj = 0; bj < 2; ++bj) {
                    const f32x4 x1 = acc[ai][bj][m][0] * sc, x2 = acc[ai][bj][m][1] * sc;
                    f32x4 o1, o2;
                    o1[0] = x1[0] * cs0[0] - x2[0] * cs0[1]; o2[0] = x2[0] * cs0[0] + x1[0] * cs0[1];
                    o1[1] = x1[1] * cs0[2] - x2[1] * cs0[3]; o2[1] = x2[1] * cs0[2] + x1[1] * cs0[3];
                    o1[2] = x1[2] * cs1[0] - x2[2] * cs1[1]; o2[2] = x2[2] * cs1[0] + x1[2] * cs1[1];
                    o1[3] = x1[3] * cs1[2] - x2[3] * cs1[3]; o2[3] = x2[3] * cs1[2] + x1[3] * cs1[3];
                    bf16* p = QKV + (size_t)row * 1536 + col0 + bj * 128;
                    u32x2 w1, w2; w1.x = pk2(o1[0], o1[1]); w1.y = pk2(o1[2], o1[3]); w2.x = pk2(o2[0], o2[1]); w2.y = pk2(o2[2], o2[3]);
                    *(u32x2*)p = w1; *(u32x2*)(p + 16) = w2;
                }
            }
    }
};

template <class Epi>
__device__ __forceinline__ void run_gemm(const Fr& F, const bf16* A, const bf16* Bt, int M, int N, int K, const Epi& E) {
    pg8::Gemm g{A, Bt, M, N, K, K}; pg8::StaticOrder S; S.init(M, N, F.G, F.bx);
    pg8::gemm_phase<Epi, pg8::StaticOrder, true, true>(F.lds, g, S, E, F.tid);
}


struct EpiSlab {
    static constexpr bool PERM = false, AFTER_DRAIN = false;
    float* SL; const float* modl; int gidx; float coef;
    __device__ __forceinline__ void operator()(const f32x4 (&acc)[2][2][4][2], const Unit& u, int wr, int wc, int fr, int fq) const {
        const float* gp = modl + NMODV + gidx * 1024;
        int z0 = 0; asm volatile("" : "+v"(z0));
        const int row0 = u.ks * 256 + wr * 64 + fr + z0, col0 = u.pn * 256 + wc * 32 + 4 * fq;
#pragma unroll
        for (int bj = 0; bj < 2; ++bj)
#pragma unroll
            for (int n = 0; n < 2; ++n) {
                const int col = col0 + bj * 128 + n * 16;
                const f32x4 gv = *(const f32x4*)(gp + col) * coef;
#pragma unroll
                for (int ai = 0; ai < 2; ++ai)
#pragma unroll
                    for (int m = 0; m < 4; ++m) *(f32x4*)(SL + (size_t)(row0 + ai * 128 + m * 16) * D + col) = gv * acc[ai][bj][m][n];
            }
    }
};
__device__ __forceinline__ void run_resid_gemm(const Fr& F, const bf16* A, const bf16* Bt, int K, bool with_ctx, const float* modl, int gidx, float coef) {
    { EpiResid E{F.X, modl, gidx, coef}; run_gemm(F, A, Bt, SEQ, D, K, E); }
    if (with_ctx) {
        pg8::Gemm g{A, Bt, MT, D, K, 256}; pg8::SplitKOrder S{64, 4, K / 256, F.G, F.bx};
        EpiSlab E{F.SLAB, modl, gidx, coef};
        int tid2 = F.tid; asm volatile("" : "+v"(tid2));
        pg8::gemm_phase<EpiSlab, pg8::SplitKOrder, false, false>(F.lds, g, S, E, tid2);
    }
}
__device__ __forceinline__ void xpose_item(const float* W, int K, int N, bf16* WT, int kb, int nb, int dst_row0, LAS float* scr, int lane) {
    const int k0 = 64 * kb, n0 = 32 * nb;
    float tv[32];
#pragma unroll
    for (int i = 0; i < 32; ++i) tv[i] = W[(size_t)(k0 + 2 * i + (lane >> 5)) * N + n0 + (lane & 31)];
#pragma unroll
    for (int i = 0; i < 32; ++i) scr[(2 * i + (lane >> 5)) * 33 + (lane & 31)] = tv[i];
    LDS_WAIT(); asm volatile("" ::: "memory");
    const int c = lane & 7;
#pragma unroll
    for (int j = 0; j < 4; ++j) { const int n = (lane >> 3) + 8 * j; const LAS float* s = scr + (8 * c) * 33 + n;
        u32x4 o; o.x = pk2(s[0 * 33], s[1 * 33]); o.y = pk2(s[2 * 33], s[3 * 33]); o.z = pk2(s[4 * 33], s[5 * 33]); o.w = pk2(s[6 * 33], s[7 * 33]);
        *(u32x4*)(WT + (size_t)(dst_row0 + n) * K + k0 + 8 * c) = o; }
    LDS_WAIT(); asm volatile("" ::: "memory");
}

__device__ __forceinline__ void ph_prologue(const Fr& F) {
    LAS float* scr = (LAS float*)(F.lds + F.wave * 16384);
    const int gw = F.bx * 8 + F.wave, NGW = F.G * 8;
    constexpr int C1 = 22528, C2 = C1 + 11264, C3 = C2 + 3104, C4 = C3 + 1024, C5 = C4 + 1536, C6 = C5 + 768, C7 = C6 + 192, C8 = C7 + 192, C9 = C8 + 768, C10 = C9 + 512;
    for (int it = gw; it < C10; it += NGW) {
        if (it < C1) { const int mat = it / 2816, r = it % 2816, kb = r / 176, nb = r % 176, n0 = 32 * nb, half = n0 / DFF, jj = n0 % DFF;
            xpose_item(F.ffn_w_in + (size_t)mat * D * 2 * DFF, D, 2 * DFF, F.WFI + (size_t)mat * 2 * DFF * D, kb, nb, (jj / 128) * 256 + half * 128 + (jj % 128), scr, F.lane); }
        else if (it < C2) { const int q = it - C1, mat = q / 1408, r = q % 1408; xpose_item(F.ffn_w_out + (size_t)mat * DFF * D, DFF, D, F.WFO + (size_t)mat * D * DFF, r / 32, r % 32, 32 * (r % 32), scr, F.lane); }
        else if (it < C3) { const int q = it - C2, mat = q / 1552, r = q % 1552; xpose_item(F.gla_w_in + (size_t)mat * D * 3104, D, 3104, F.WGI + (size_t)mat * GLA_NP * D, r / 97, r % 97, 32 * (r % 97), scr, F.lane); }
        else if (it < C4) { const int q = it - C3, mat = q / 512, r = q % 512; xpose_item(F.gla_w_out + (size_t)mat * D * D, D, D, F.WGO + (size_t)mat * D * D, r / 32, r % 32, 32 * (r % 32), scr, F.lane); }
        else if (it < C5) { const int r = it - C4; xpose_item(F.rg_w_in, D, 3072, F.WRI, r / 96, r % 96, 32 * (r % 96), scr, F.lane); }
        else if (it < C6) { const int r = it - C5; xpose_item(F.rg_w_out, 1536, D, F.WRO, r / 32, r % 32, 32 * (r % 32), scr, F.lane); }
        else if (it < C7) { const int q = it - C6, mat = q / 8, r = q % 8; xpose_item(F.rg_w_a + (size_t)mat * 16384, 128, 128, F.WRA + (size_t)mat * 16384, r / 4, r % 4, 32 * (r % 4), scr, F.lane); }
        else if (it < C8) { const int q = it - C7, mat = q / 8, r = q % 8; xpose_item(F.rg_w_x + (size_t)mat * 16384, 128, 128, F.WRX + (size_t)mat * 16384, r / 4, r % 4, 32 * (r % 4), scr, F.lane); }
        else if (it < C9) { const int r = it - C8; xpose_item(F.swa_w_qkv, D, 1536, F.WSQ, r / 48, r % 48, 32 * (r % 48), scr, F.lane); }
        else { const int r = it - C9; xpose_item(F.swa_w_out, D, D, F.WSO, r / 32, r % 32, 32 * (r % 32), scr, F.lane); }
    }
    const int gt = F.bx * 512 + F.tid, NGT = F.G * 512;
    for (int i = gt; i < 2 * 224 * (D / 8); i += NGT) { const int mat = i / (224 * 128), r = i % (224 * 128); *(u32x4*)(F.WGI + (size_t)mat * GLA_NP * D + (size_t)3104 * D + (size_t)r * 8) = (u32x4){0u, 0u, 0u, 0u}; }
    for (int i = gt; i < MT * (D / 4); i += NGT) { const f32x4 v = (i < SEQ * (D / 4)) ? ((const f32x4*)F.x)[i] : ((const f32x4*)F.ctx)[i - SEQ * (D / 4)]; ((f32x4*)F.X)[i] = v; }
    if (gt == 0) *(unsigned*)(F.ws + 512 * 1024) = 0u;
    if (gt < 4096) { const int id = gt >> 4, f = gt & 15; const float freq = powf(10000.0f, -(float)(2 * f) / 32.0f); const float ang = (float)id * freq;
        const double rev = (double)ang * 0.15915494309189535; const float rr = (float)(rev - rint(rev));
        F.ROPE[2 * gt] = __builtin_amdgcn_cosf(rr); F.ROPE[2 * gt + 1] = __builtin_amdgcn_sinf(rr); }
    __syncthreads();
    LAS f32x4* red = (LAS f32x4*)F.lds;
    for (int b = F.bx; b < 4 * 72; b += F.G) {
        const int li = b / 72, c0 = (b % 72) * 128 + 2 * F.lane;
        const float* wp = F.ada_w + (size_t)li * D * NMODV + (size_t)(F.wave * 128) * NMODV + c0;
        float a0 = 0.f, a1 = 0.f, b0 = 0.f, b1 = 0.f;
#pragma unroll 32
        for (int k = 0; k < 128; ++k) { const f32x2 w = *(const f32x2*)(wp + (size_t)k * NMODV); const float sl = siluf_(F.c[F.wave * 128 + k]), sc = siluf_(F.c_ctx[F.wave * 128 + k]);
            a0 += sl * w.x; a1 += sl * w.y; b0 += sc * w.x; b1 += sc * w.y; }
        red[F.wave * 64 + F.lane] = (f32x4){a0, a1, b0, b1};
        __syncthreads();
        if (F.wave == 0) { f32x4 s = red[F.lane];
#pragma unroll
            for (int w = 1; w < 8; ++w) s += red[w * 64 + F.lane];
            const f32x2 bb = *(const f32x2*)(F.ada_b + (size_t)li * NMODV + c0);
            *(f32x2*)(F.MOD + (size_t)(li * 2 + 0) * NMODV + c0) = (f32x2){s[0] + bb.x, s[1] + bb.y};
            *(f32x2*)(F.MOD + (size_t)(li * 2 + 1) * NMODV + c0) = (f32x2){s[2] + bb.x, s[3] + bb.y}; }
        __syncthreads();
    }
}

__device__ __forceinline__ void ph_norm(const Fr& F, int layer, int k, int mrows, int nks) {
    const float* g = F.norm_g + (size_t)(layer * 3 + k) * D;
    const int gw = F.bx * 8 + F.wave, NGW = F.G * 8;
    f32x4 gs[4], sh[4];
    { const float* mod = F.MOD + (size_t)(layer * 2) * NMODV; const float* shift = mod + (3 * k) * 1024; const float* scale = mod + (3 * k + 1) * 1024;
#pragma unroll
      for (int j = 0; j < 4; ++j) { const int col = 4 * (F.lane + 64 * j); gs[j] = *(const f32x4*)(g + col) * (*(const f32x4*)(scale + col) + 1.0f); sh[j] = *(const f32x4*)(shift + col); } }
    int m = gw;
    f32x4 v[4];
    if (m < mrows) { const f32x4* xr = (const f32x4*)(F.X + (size_t)m * D) + F.lane;
#pragma unroll
        for (int j = 0; j < 4; ++j) v[j] = xr[64 * j]; }
    while (m < mrows) {
        const int mn = m + NGW;
        f32x4 vn[4];
        if (mn < mrows) { const f32x4* xr = (const f32x4*)(F.X + (size_t)mn * D) + F.lane;
#pragma unroll
            for (int j = 0; j < 4; ++j) vn[j] = xr[64 * j]; }
        f32x4 gsr[4], shr[4];
#pragma unroll
        for (int j = 0; j < 4; ++j) { gsr[j] = gs[j]; shr[j] = sh[j]; }
        if (m >= SEQ) {
            const float* mod = F.MOD + (size_t)(layer * 2 + 1) * NMODV; const float* shift = mod + (3 * k) * 1024; const float* scale = mod + (3 * k + 1) * 1024;
#pragma unroll
            for (int j = 0; j < 4; ++j) { const int col = 4 * (F.lane + 64 * j); gsr[j] = *(const f32x4*)(g + col) * (*(const f32x4*)(scale + col) + 1.0f); shr[j] = *(const f32x4*)(shift + col); }
            if (nks > 0) {
                for (int ks = 0; ks < nks; ks += 4) {
                    f32x4 t[4][4];
#pragma unroll
                    for (int i = 0; i < 4; ++i) { const f32x4* sp = (const f32x4*)(F.SLAB + ((size_t)(ks + i < nks ? ks + i : ks) * 256 + (m - SEQ)) * D) + F.lane;
#pragma unroll
                        for (int j = 0; j < 4; ++j) t[i][j] = sp[64 * j]; }
#pragma unroll
                    for (int i = 0; i < 4; ++i) if (ks + i < nks) {
#pragma unroll
                        for (int j = 0; j < 4; ++j) v[j] += t[i][j]; }
                }
                f32x4* xw = (f32x4*)(F.X + (size_t)m * D) + F.lane;
#pragma unroll
                for (int j = 0; j < 4; ++j) xw[64 * j] = v[j];
            }
        }
        float ss = 0.f;
#pragma unroll
        for (int j = 0; j < 4; ++j) ss += (v[j].x * v[j].x + v[j].y * v[j].y) + (v[j].z * v[j].z + v[j].w * v[j].w);
        const float rstd = __builtin_amdgcn_rsqf(wave_sum(ss, F.lane) * (1.0f / D) + NORM_EPS);
        u32x2* o8 = (u32x2*)(F.XN + (size_t)m * D) + F.lane;
#pragma unroll
        for (int j = 0; j < 4; ++j) { const f32x4 y = v[j] * rstd * gsr[j] + shr[j]; u32x2 w; w.x = pk2(y[0], y[1]); w.y = pk2(y[2], y[3]); o8[64 * j] = w; }
#pragma unroll
        for (int j = 0; j < 4; ++j) v[j] = vn[j];
        m = mn;
    }
}
__device__ __forceinline__ void ph_final(const Fr& F) {
    const int gw = F.bx * 8 + F.wave, NGW = F.G * 8;
    for (int m = gw; m < SEQ; m += NGW) {
        const f32x4* xr = (const f32x4*)(F.X + (size_t)m * D) + F.lane;
        f32x4 v[4]; float ss = 0.f;
#pragma unroll
        for (int j = 0; j < 4; ++j) { v[j] = xr[64 * j]; ss += (v[j].x * v[j].x + v[j].y * v[j].y) + (v[j].z * v[j].z + v[j].w * v[j].w); }
        const float rstd = __builtin_amdgcn_rsqf(wave_sum(ss, F.lane) * (1.0f / D) + NORM_EPS);
        f32x4* o = (f32x4*)(F.out + (size_t)m * D) + F.lane;
#pragma unroll
        for (int j = 0; j < 4; ++j) { const f32x4 gg = *(const f32x4*)(F.final_g + 4 * (F.lane + 64 * j)); o[64 * j] = v[j] * rstd * gg; }
    }
}

__device__ __forceinline__ void gla_b_unit(const Fr& F, int j, int n, int h, int z) {
    LAS unsigned char* lds = F.lds;
    LAS float* sLR = (LAS float*)(lds);
    LAS float* sW = (LAS float*)(lds + 4096);
    LAS float* sB = (LAS float*)(lds + 12288);
    LAS float* sSeg = (LAS float*)(lds + 45056);
    LAS bf16* sVT = (LAS bf16*)(lds + 47104);
    LAS bf16* sKT = (LAS bf16*)(lds + 83968);
    const int tid = F.tid, row0 = 64 * n;
    float lrv[2], wav[4];
#pragma unroll
    for (int i = 0; i < 2; ++i) { const int ii = tid + 512 * i, t = ii >> 4, r = ii & 15; lrv[i] = F.LR[(size_t)(row0 + t) * 32 + z * 16 + r]; }
#pragma unroll
    for (int i = 0; i < 4; ++i) { const int ii = tid + 512 * i, r = ii >> 7, k = ii & 127; wav[i] = F.gla_w_a2[((size_t)(j * 2 + z) * 16 + r) * 512 + h * 128 + k]; }
    const int tS = tid >> 3, d0S = (tid & 7) * 16, rowS = row0 + tS, e0S = (tid & 7) * 32;
    const bf16* qpS = F.P + (size_t)rowS * 3072 + h * 128 + d0S;
    const bf16x8 q0 = *(const bf16x8*)qpS, q1 = *(const bf16x8*)(qpS + 8), k0 = *(const bf16x8*)(qpS + 512), k1 = *(const bf16x8*)(qpS + 520);
    const bf16* vpS = F.P + (size_t)rowS * 3072 + 1024 + h * 256 + e0S;
    const bf16x8 vv0 = *(const bf16x8*)vpS, vv1 = *(const bf16x8*)(vpS + 8), vv2 = *(const bf16x8*)(vpS + 16), vv3 = *(const bf16x8*)(vpS + 24);
    const float bias = F.gla_b_a[(size_t)(j * 2 + z) * 512 + h * 128 + (tid & 127)];
#pragma unroll
    for (int i = 0; i < 2; ++i) sLR[tid + 512 * i] = lrv[i];
#pragma unroll
    for (int i = 0; i < 4; ++i) sW[tid + 512 * i] = wav[i];
#pragma unroll
    for (int i = 0; i < 8; ++i) { sVT[(e0S + i) * 72 + tS] = (unsigned short)vv0[i]; sVT[(e0S + 8 + i) * 72 + tS] = (unsigned short)vv1[i]; sVT[(e0S + 16 + i) * 72 + tS] = (unsigned short)vv2[i]; sVT[(e0S + 24 + i) * 72 + tS] = (unsigned short)vv3[i]; }
    __syncthreads();
    {
        const int k = tid & 127, tq = tid >> 7;
        float wv[16];
#pragma unroll
        for (int r = 0; r < 16; ++r) wv[r] = sW[r * 128 + k];
        float gv[16];
#pragma unroll
        for (int i = 0; i < 16; ++i) { const int t = tq * 16 + i; float a = bias;
            const f32x4 l0 = *(const LAS f32x4*)(sLR + t * 16), l1 = *(const LAS f32x4*)(sLR + t * 16 + 4), l2 = *(const LAS f32x4*)(sLR + t * 16 + 8), l3 = *(const LAS f32x4*)(sLR + t * 16 + 12);
#pragma unroll
            for (int r = 0; r < 4; ++r) { a += l0[r] * wv[r]; a += l1[r] * wv[4 + r]; a += l2[r] * wv[8 + r]; a += l3[r] * wv[12 + r]; }
            gv[i] = logsigmoid_(a) * (1.0f / 16.0f); }
        float run = 0.f;
        if (z == 0) {
#pragma unroll
            for (int i = 0; i < 16; ++i) { run += gv[i]; gv[i] = run; }
        } else {
#pragma unroll
            for (int i = 15; i >= 0; --i) { run += gv[i]; gv[i] = run; }
        }
        sSeg[tq * 128 + k] = run;
        __syncthreads();
        float off = 0.f;
#pragma unroll
        for (int q = 0; q < 4; ++q) { const float sv = sSeg[q * 128 + k]; if (z == 0 ? (q < tq) : (q > tq)) off += sv; }
#pragma unroll
        for (int i = 0; i < 16; ++i) sB[(tq * 16 + i) * 128 + k] = gv[i] + off;
    }
    __syncthreads();
    const int tl = (z == 0) ? 63 : 0;
    {
        const int t = tid >> 3, d0 = (tid & 7) * 16, row = row0 + t;
        float qd[16], kn[16];
#pragma unroll
        for (int i = 0; i < 16; ++i) {
            const float bt = sB[t * 128 + d0 + i], bl = sB[tl * 128 + d0 + i];
            const float qv = bf2f((unsigned short)(i < 8 ? q0[i] : q1[i - 8])), kv = bf2f((unsigned short)(i < 8 ? k0[i] : k1[i - 8]));
            qd[i] = qv * __expf(bt); kn[i] = kv * __expf(-bt);
            sKT[(d0 + i) * 72 + t] = f2bf1(kv * __expf(bl - bt));
        }
        u32x4 w0, w1;
        w0.x = pk2(qd[0], qd[1]); w0.y = pk2(qd[2], qd[3]); w0.z = pk2(qd[4], qd[5]); w0.w = pk2(qd[6], qd[7]);
        w1.x = pk2(qd[8], qd[9]); w1.y = pk2(qd[10], qd[11]); w1.z = pk2(qd[12], qd[13]); w1.w = pk2(qd[14], qd[15]);
        bf16* qo = F.QD + ((size_t)z * MT + row) * 512 + h * 128 + d0; *(u32x4*)qo = w0; *(u32x4*)(qo + 8) = w1;
        w0.x = pk2(kn[0], kn[1]); w0.y = pk2(kn[2], kn[3]); w0.z = pk2(kn[4], kn[5]); w0.w = pk2(kn[6], kn[7]);
        w1.x = pk2(kn[8], kn[9]); w1.y = pk2(kn[10], kn[11]); w1.z = pk2(kn[12], kn[13]); w1.w = pk2(kn[14], kn[15]);
        bf16* ko = F.KN + ((size_t)z * MT + row) * 512 + h * 128 + d0; *(u32x4*)ko = w0; *(u32x4*)(ko + 8) = w1;
        if (tid < 128) F.DEC[(size_t)(z * NCH + n) * 512 + h * 128 + tid] = __expf(sB[tl * 128 + tid]);
    }
    __syncthreads();
    {
        const int r = F.lane & 15, q = F.lane >> 4, w = F.wave;
        const bf16x8 a0 = *(const LAS bf16x8*)(sKT + (w * 16 + r) * 72 + q * 8), a1 = *(const LAS bf16x8*)(sKT + (w * 16 + r) * 72 + 32 + q * 8);
        bf16* USp = F.US + ((size_t)(z * NCH + n) * 4 + h) * 32768;
#pragma unroll 4
        for (int et = 0; et < 16; ++et) {
            const bf16x8 b0 = *(const LAS bf16x8*)(sVT + (et * 16 + r) * 72 + q * 8), b1 = *(const LAS bf16x8*)(sVT + (et * 16 + r) * 72 + 32 + q * 8);
            f32x4 acc = {0.f, 0.f, 0.f, 0.f}; acc = mma(a0, b0, acc); acc = mma(a1, b1, acc);
            u32x2 o; o.x = pk2(acc[0], acc[1]); o.y = pk2(acc[2], acc[3]);
            *(u32x2*)(USp + (size_t)((et * 8 + w) * 16 + r) * 16 + 4 * q) = o;
        }
    }
    __syncthreads();
}
__device__ __forceinline__ void gla_scan(const Fr& F) {
    for (int idx = F.bx * 512 + F.tid; idx < 131072; idx += F.G * 512) {
        const int o2 = 2 * (idx & 16383), h = (idx >> 14) & 3, z = idx >> 16, dd = ((o2 >> 8) & 7) * 16 + (o2 & 15);
        float s0 = 0.f, s1 = 0.f;
        constexpr int NB = 13;
        unsigned uA[NB], uB[NB]; f32x2 dA[NB], dB[NB]; unsigned *pA[NB], *pB[NB];
#define GS_LOAD(U, Dc, P, s_) { _Pragma("unroll") for (int i = 0; i < NB; ++i) { const int ss = (s_) + i, n = z ? (NCH - 1 - ss) : (ss < 4 ? 256 + ss : ss - 4); \
            P[i] = (unsigned*)(F.US + ((size_t)(z * NCH + n) * 4 + h) * 32768 + o2); U[i] = *P[i]; \
            Dc[i] = *(const f32x2*)(F.DEC + (size_t)(z * NCH + n) * 512 + h * 128 + dd); } }
#define GS_PROC(U, Dc, P) { _Pragma("unroll") for (int i = 0; i < NB; ++i) { *P[i] = pk2(s0, s1); s0 = Dc[i].x * s0 + bflo(U[i]); s1 = Dc[i].y * s1 + bfhi(U[i]); } }
        GS_LOAD(uA, dA, pA, 0)
#pragma unroll 1
        for (int s = 0; s < NCH; s += 2 * NB) {
            GS_LOAD(uB, dB, pB, s + NB)
            GS_PROC(uA, dA, pA)
            if (s + 2 * NB < NCH) GS_LOAD(uA, dA, pA, s + 2 * NB)
            GS_PROC(uB, dB, pB)
        }
#undef GS_LOAD
#undef GS_PROC
    }
}
__device__ __forceinline__ void gla_d_unit(const Fr& F, int j, int n, int h) {
    LAS unsigned char* lds = F.lds;
    LAS bf16* sVT = (LAS bf16*)(lds);
    LAS bf16* sAtt = (LAS bf16*)(lds + 36864);
    LAS float* sSS = (LAS float*)(lds + 55296);
    const int tid = F.tid, row0 = 64 * n, r = F.lane & 15, q = F.lane >> 4, w = F.wave;
    bf16x8 usf[2][4][2];
#pragma unroll
    for (int z = 0; z < 2; ++z) { const bf16* USz = F.US + ((size_t)(z * NCH + n) * 4 + h) * 32768;
#pragma unroll
        for (int ks = 0; ks < 4; ++ks) { const int dt = 2 * ks + (q >> 1), dl = 8 * (q & 1);
            usf[z][ks][0] = *(const bf16x8*)(USz + (size_t)(((2 * w) * 8 + dt) * 16 + r) * 16 + dl); usf[z][ks][1] = *(const bf16x8*)(USz + (size_t)(((2 * w + 1) * 8 + dt) * 16 + r) * 16 + dl); } }
    {
        const int t = tid >> 3, e0 = (tid & 7) * 32;
        const bf16* vp = F.P + (size_t)(row0 + t) * 3072 + 1024 + h * 256 + e0;
#pragma unroll
        for (int c = 0; c < 4; ++c) { const bf16x8 vv = *(const bf16x8*)(vp + 8 * c);
#pragma unroll
            for (int i = 0; i < 8; ++i) sVT[(e0 + 8 * c + i) * 72 + t] = (unsigned short)vv[i]; }
    }
    {
        const int z = w >> 2, tt = w & 3;
        const bf16* qdp = F.QD + ((size_t)z * MT + row0 + tt * 16 + r) * 512 + h * 128 + 8 * q;
        bf16x8 bq[4];
#pragma unroll
        for (int ks = 0; ks < 4; ++ks) bq[ks] = *(const bf16x8*)(qdp + 32 * ks);
        const int t = tt * 16 + r;
#pragma unroll
        for (int st = 0; st < 4; ++st) {
            const bf16* knp = F.KN + ((size_t)z * MT + row0 + st * 16 + r) * 512 + h * 128 + 8 * q;
            f32x4 acc = {0.f, 0.f, 0.f, 0.f};
#pragma unroll
            for (int ks = 0; ks < 4; ++ks) acc = mma(*(const bf16x8*)(knp + 32 * ks), bq[ks], acc);
#pragma unroll
            for (int jj = 0; jj < 4; ++jj) { const int s = st * 16 + 4 * q + jj; const bool keep = (z == 0) ? (s <= t) : (s >= t); if (!keep) acc[jj] = 0.f; }
            u32x2 o; o.x = pk2(acc[0], acc[1]); o.y = pk2(acc[2], acc[3]);
            *(LAS u32x2*)(sAtt + (z * 64 + t) * 72 + st * 16 + 4 * q) = o;
        }
    }
    __syncthreads();
    f32x4 acc[2][4];
#pragma unroll
    for (int ei = 0; ei < 2; ++ei)
#pragma unroll
        for (int tt = 0; tt < 4; ++tt) acc[ei][tt] = (f32x4){0.f, 0.f, 0.f, 0.f};
#pragma unroll
    for (int z = 0; z < 2; ++z) {
#pragma unroll
        for (int ks = 0; ks < 2; ++ks) {
            const bf16x8 a0 = *(const LAS bf16x8*)(sVT + (32 * w + r) * 72 + ks * 32 + 8 * q), a1 = *(const LAS bf16x8*)(sVT + (32 * w + 16 + r) * 72 + ks * 32 + 8 * q);
#pragma unroll
            for (int tt = 0; tt < 4; ++tt) { const bf16x8 b = *(const LAS bf16x8*)(sAtt + (z * 64 + tt * 16 + r) * 72 + ks * 32 + 8 * q);
                acc[0][tt] = mma(a0, b, acc[0][tt]); acc[1][tt] = mma(a1, b, acc[1][tt]); }
        }
        const bf16* QDz = F.QD + ((size_t)z * MT + row0 + r) * 512 + h * 128 + 8 * q;
#pragma unroll
        for (int ks = 0; ks < 4; ++ks) {
            const bf16x8 a0 = usf[z][ks][0], a1 = usf[z][ks][1];
#pragma unroll
            for (int tt = 0; tt < 4; ++tt) { const bf16x8 b = *(const bf16x8*)(QDz + (size_t)(tt * 16) * 512 + ks * 32);
                acc[0][tt] = mma(a0, b, acc[0][tt]); acc[1][tt] = mma(a1, b, acc[1][tt]); }
        }
    }
#pragma unroll
    for (int tt = 0; tt < 4; ++tt) {
        float ss = 0.f;
#pragma unroll
        for (int ei = 0; ei < 2; ++ei)
#pragma unroll
            for (int jj = 0; jj < 4; ++jj) ss += acc[ei][tt][jj] * acc[ei][tt][jj];
        ss += shx(ss, 16, F.lane); ss += shx(ss, 32, F.lane);
        if (q == 0) sSS[w * 64 + tt * 16 + r] = ss;
    }
    __syncthreads();
#pragma unroll
    for (int tt = 0; tt < 4; ++tt) {
        float tot = 0.f;
#pragma unroll
        for (int ww = 0; ww < 8; ++ww) tot += sSS[ww * 64 + tt * 16 + r];
        const float rstd = __builtin_amdgcn_rsqf(tot * (1.0f / 256.0f) + NORM_EPS);
        const size_t row = (size_t)(row0 + tt * 16 + r);
#pragma unroll
        for (int ei = 0; ei < 2; ++ei) {
            const int e = 32 * w + 16 * ei + 4 * q;
            const f32x4 g4 = *(const f32x4*)(F.gla_norm_g + (size_t)j * 256 + e);
            const u32x2 og = *(const u32x2*)(F.P + row * 3072 + 2048 + h * 256 + e);
            const float o0 = acc[ei][tt][0] * rstd * g4[0] * siluf_(bflo(og.x)), o1 = acc[ei][tt][1] * rstd * g4[1] * siluf_(bfhi(og.x));
            const float o2 = acc[ei][tt][2] * rstd * g4[2] * siluf_(bflo(og.y)), o3 = acc[ei][tt][3] * rstd * g4[3] * siluf_(bfhi(og.y));
            u32x2 o; o.x = pk2(o0, o1); o.y = pk2(o2, o3);
            *(u32x2*)(F.OB + row * 1024 + h * 256 + e) = o;
        }
    }
    __syncthreads();
}

__device__ __forceinline__ void rg_unit(const Fr& F, int n, int nb, int mode, int buf) {
    LAS unsigned char* lds = F.lds;
    LAS bf16* sXC = (LAS bf16*)(lds + buf * 17408);
    const int tid = F.tid, row0 = 64 * n, w = F.wave;
    LAS float* sA = (LAS float*)(lds + 34816 + w * 12288);
    LAS float* sU = sA + 1024;
    LAS float* sHS = sA + 2048;
    const int lo = (n >= 256) ? SEQ : 0, hi = (n >= 256) ? MT : SEQ;
    {
        const int cc = tid & 127, tq = tid >> 7, c = 128 * nb + cc;
        const float w0 = F.rg_conv_w[0 * 1536 + c], w1 = F.rg_conv_w[1 * 1536 + c], w2 = F.rg_conv_w[2 * 1536 + c], w3 = F.rg_conv_w[3 * 1536 + c], cb = F.rg_conv_b[c];
        const int tb = row0 + tq * 16;
        float xm2, xm1, x0, xp1;
        { const int r = tb - 2; xm2 = (r >= lo && r < hi) ? bf2f(F.XR[(size_t)r * 1536 + c]) : 0.f; }
        { const int r = tb - 1; xm1 = (r >= lo && r < hi) ? bf2f(F.XR[(size_t)r * 1536 + c]) : 0.f; }
        x0 = bf2f(F.XR[(size_t)tb * 1536 + c]);
#pragma unroll
        for (int i = 0; i < 16; ++i) {
            const int r = tb + i + 1; xp1 = (r < hi) ? bf2f(F.XR[(size_t)r * 1536 + c]) : 0.f;
            const float xc = cb + w0 * xm2 + w1 * xm1 + w2 * x0 + w3 * xp1;
            sXC[(tq * 16 + i) * 136 + cc] = f2bf1(xc);
            xm2 = xm1; xm1 = x0; x0 = xp1;
        }
    }
    __syncthreads();
    const int r = F.lane & 15, q = F.lane >> 4;
    const int c16 = 128 * nb + 16 * w;
#pragma unroll 1
    for (int z = 0; z < 2; ++z) {
        {
            const bf16* wa = F.WRA + ((size_t)(z * 12 + nb) * 128 + 16 * w + r) * 128 + 8 * q;
            const bf16* wx = F.WRX + ((size_t)(z * 12 + nb) * 128 + 16 * w + r) * 128 + 8 * q;
            f32x4 ra[4], ia[4];
#pragma unroll
            for (int tt = 0; tt < 4; ++tt) { ra[tt] = (f32x4){0.f, 0.f, 0.f, 0.f}; ia[tt] = (f32x4){0.f, 0.f, 0.f, 0.f}; }
#pragma unroll
            for (int ks = 0; ks < 4; ++ks) {
                const bf16x8 ar = *(const bf16x8*)(wa + 32 * ks), ai = *(const bf16x8*)(wx + 32 * ks);
#pragma unroll
                for (int tt = 0; tt < 4; ++tt) { const bf16x8 b = *(const LAS bf16x8*)(sXC + (tt * 16 + r) * 136 + ks * 32 + 8 * q); ra[tt] = mma(ar, b, ra[tt]); ia[tt] = mma(ai, b, ia[tt]); }
            }
            const int cl = 16 * w + 4 * q, c4 = 128 * nb + cl;
            const f32x4 ba = *(const f32x4*)(F.rg_b_a + z * 1536 + c4), bx = *(const f32x4*)(F.rg_b_x + z * 1536 + c4), lam = *(const f32x4*)(F.rg_lam + z * 1536 + c4);
            f32x4 coef;
#pragma unroll
            for (int jj = 0; jj < 4; ++jj) coef[jj] = -8.0f * softplus_(-lam[jj]);
#pragma unroll
            for (int tt = 0; tt < 4; ++tt) {
                const int t = tt * 16 + r;
                const u32x2 xw = *(const LAS u32x2*)(sXC + t * 136 + cl);
                const float xc[4] = {bflo(xw.x), bfhi(xw.x), bflo(xw.y), bfhi(xw.y)};
                f32x4 av, uv, lav;
#pragma unroll
                for (int jj = 0; jj < 4; ++jj) {
                    const float rr = sigmoidf_(ra[tt][jj] + ba[jj]), ii = sigmoidf_(ia[tt][jj] + bx[jj]);
                    const float la = coef[jj] * rr, x2 = 2.0f * la;
                    const float a = __expf(la);
                    const float ser = -x2 * (1.0f + x2 * (0.5f + x2 * (0.16666667f + x2 * (0.041666668f + x2 * 0.008333334f))));
                    const float om = (x2 > -0.25f) ? ser : (1.0f - a * a);
                    av[jj] = a; uv[jj] = __builtin_amdgcn_sqrtf(om) * (ii * xc[jj]); lav[jj] = la;
                }
                *(LAS f32x4*)(sA + t * 16 + 4 * q) = av; *(LAS f32x4*)(sU + t * 16 + 4 * q) = uv;
                { const size_t go = ((size_t)z * MT + row0 + t) * 1536 + c4; u32x2 lw, uw; lw.x = pk2(lav[0], lav[1]); lw.y = pk2(lav[2], lav[3]); uw.x = pk2(uv[0], uv[1]); uw.y = pk2(uv[2], uv[3]);
                  *(u32x2*)(F.LAg + go) = lw; *(u32x2*)(F.UUg + go) = uw; }
            }
        }
        asm volatile("s_waitcnt lgkmcnt(0)" ::: "memory");
        {
            const int cl = F.lane & 15, seg = F.lane >> 4, c = c16 + cl;
            float Pp = 1.f, Hh = 0.f;
            if (z == 0) {
#pragma unroll
                for (int i = 0; i < 16; ++i) { const int t = seg * 16 + i; const float a = sA[t * 16 + cl], u = sU[t * 16 + cl]; Hh = a * Hh + u; Pp *= a; } }
            else {
#pragma unroll
                for (int i = 15; i >= 0; --i) { const int t = seg * 16 + i; const float a = sA[t * 16 + cl], u = sU[t * 16 + cl]; Hh = a * Hh + u; Pp *= a; } }
            float sp[4], sh[4];
            sp[0] = Pp; sh[0] = Hh;
            sp[1] = shx(Pp, 16, F.lane); sh[1] = shx(Hh, 16, F.lane);
            sp[2] = shx(Pp, 32, F.lane); sh[2] = shx(Hh, 32, F.lane);
            sp[3] = shx(Pp, 48, F.lane); sh[3] = shx(Hh, 48, F.lane);
            if (mode == 0) {
                float Pt = 1.f, Ht = 0.f;
#pragma unroll
                for (int s2 = 0; s2 < 4; ++s2) { const int sg = (z == 0) ? s2 : 3 - s2;
                    float p_ = sp[0], h_ = sh[0];
#pragma unroll
                    for (int x = 1; x < 4; ++x) if ((seg ^ x) == sg) { p_ = sp[x]; h_ = sh[x]; }
                    Ht = p_ * Ht + h_; Pt *= p_; }
                if (seg == 0) { F.AP[(size_t)(z * NCH + n) * 1536 + c] = Pt; F.HE[(size_t)(z * NCH + n) * 1536 + c] = Ht; }
            } else {
                float hh = F.CIN[(size_t)(z * NCH + n) * 1536 + c];
#pragma unroll
                for (int s2 = 0; s2 < 4; ++s2) { const int sg = (z == 0) ? s2 : 3 - s2; const bool prior = (z == 0) ? (sg < seg) : (sg > seg);
                    float p_ = sp[0], h_ = sh[0];
#pragma unroll
                    for (int x = 1; x < 4; ++x) if ((seg ^ x) == sg) { p_ = sp[x]; h_ = sh[x]; }
                    if (prior) hh = p_ * hh + h_; }
                if (z == 0) {
#pragma unroll
                    for (int i = 0; i < 16; ++i) { const int t = seg * 16 + i; hh = sA[t * 16 + cl] * hh + sU[t * 16 + cl]; sHS[t * 16 + cl] = hh; } }
                else {
#pragma unroll
                    for (int i = 15; i >= 0; --i) { const int t = seg * 16 + i; hh = sA[t * 16 + cl] * hh + sU[t * 16 + cl]; sHS[t * 16 + cl] += hh; } }
            }
        }
        asm volatile("s_waitcnt lgkmcnt(0)" ::: "memory");
    }
    if (mode == 1) {
        const int t = F.lane; const size_t row = (size_t)(row0 + t);
        const u32x4 g0 = *(const u32x4*)(F.GG + row * 1536 + c16), g1 = *(const u32x4*)(F.GG + row * 1536 + c16 + 8);
        const f32x4 h0 = *(const LAS f32x4*)(sHS + t * 16), h1 = *(const LAS f32x4*)(sHS + t * 16 + 4), h2 = *(const LAS f32x4*)(sHS + t * 16 + 8), h3 = *(const LAS f32x4*)(sHS + t * 16 + 12);
        u32x4 o0, o1;
        o0.x = pk2(h0[0] * bflo(g0.x), h0[1] * bfhi(g0.x)); o0.y = pk2(h0[2] * bflo(g0.y), h0[3] * bfhi(g0.y)); o0.z = pk2(h1[0] * bflo(g0.z), h1[1] * bfhi(g0.z)); o0.w = pk2(h1[2] * bflo(g0.w), h1[3] * bfhi(g0.w));
        o1.x = pk2(h2[0] * bflo(g1.x), h2[1] * bfhi(g1.x)); o1.y = pk2(h2[2] * bflo(g1.y), h2[3] * bfhi(g1.y)); o1.z = pk2(h3[0] * bflo(g1.z), h3[1] * bfhi(g1.z)); o1.w = pk2(h3[2] * bflo(g1.w), h3[3] * bfhi(g1.w));
        *(u32x4*)(F.OB + row * 1536 + c16) = o0; *(u32x4*)(F.OB + row * 1536 + c16 + 8) = o1;
        asm volatile("s_waitcnt lgkmcnt(0)" ::: "memory");
    }
}
template <int CTRL, int RMASK> __device__ __forceinline__ float dppf(float oldv, float src) {
    return __builtin_bit_cast(float, __builtin_amdgcn_update_dpp(__builtin_bit_cast(int, oldv), __builtin_bit_cast(int, src), CTRL, RMASK, 0xf, false)); }
template <int CTRL, int RMASK> __device__ __forceinline__ void scan_step(float& P, float& H) {
    const float Pp = dppf<CTRL, RMASK>(1.0f, P), Hp = dppf<CTRL, RMASK>(0.0f, H);
    H = P * Hp + H; P = P * Pp; }
__device__ __forceinline__ void rg_unit1(const Fr& F, int n, int nb) {
    const int row0 = 64 * n, c16 = 128 * nb + 16 * F.wave, lane = F.lane;
    float hs[16];
#pragma unroll
    for (int z = 0; z < 2; ++z) {
        const int t = z ? 63 - lane : lane;
        const size_t go = ((size_t)z * MT + row0 + t) * 1536 + c16;
        const u32x4 l0 = *(const u32x4*)(F.LAg + go), l1 = *(const u32x4*)(F.LAg + go + 8), u0 = *(const u32x4*)(F.UUg + go), u1 = *(const u32x4*)(F.UUg + go + 8);
        const float* cp = F.CIN + (size_t)(z * NCH + n) * 1536 + c16;
        const f32x4 ci0 = *(const f32x4*)cp, ci1 = *(const f32x4*)(cp + 4), ci2 = *(const f32x4*)(cp + 8), ci3 = *(const f32x4*)(cp + 12);
        float P[16], H[16], ci[16];
#pragma unroll
        for (int k = 0; k < 4; ++k) { P[2 * k] = __expf(bflo(l0[k])); P[2 * k + 1] = __expf(bfhi(l0[k])); P[8 + 2 * k] = __expf(bflo(l1[k])); P[8 + 2 * k + 1] = __expf(bfhi(l1[k]));
            H[2 * k] = bflo(u0[k]); H[2 * k + 1] = bfhi(u0[k]); H[8 + 2 * k] = bflo(u1[k]); H[8 + 2 * k + 1] = bfhi(u1[k]);
            ci[k] = ci0[k]; ci[4 + k] = ci1[k]; ci[8 + k] = ci2[k]; ci[12 + k] = ci3[k]; }
#pragma unroll
        for (int ch = 0; ch < 16; ++ch) {
            float p = P[ch], h = H[ch];
            scan_step<0x111, 0xf>(p, h); scan_step<0x112, 0xf>(p, h); scan_step<0x114, 0xf>(p, h); scan_step<0x118, 0xf>(p, h);
            scan_step<0x142, 0xa>(p, h); scan_step<0x143, 0xc>(p, h);
            const float hv = p * ci[ch] + h;
            if (z == 0) hs[ch] = hv;
            else hs[ch] += __builtin_bit_cast(float, __builtin_amdgcn_ds_bpermute((63 - lane) << 2, __builtin_bit_cast(int, hv)));
        }
    }
    const size_t ro = (size_t)(row0 + lane) * 1536 + c16;
    const u32x4 g0 = *(const u32x4*)(F.GG + ro), g1 = *(const u32x4*)(F.GG + ro + 8);
    u32x4 o0, o1;
    o0.x = pk2(hs[0] * bflo(g0.x), hs[1] * bfhi(g0.x)); o0.y = pk2(hs[2] * bflo(g0.y), hs[3] * bfhi(g0.y)); o0.z = pk2(hs[4] * bflo(g0.z), hs[5] * bfhi(g0.z)); o0.w = pk2(hs[6] * bflo(g0.w), hs[7] * bfhi(g0.w));
    o1.x = pk2(hs[8] * bflo(g1.x), hs[9] * bfhi(g1.x)); o1.y = pk2(hs[10] * bflo(g1.y), hs[11] * bfhi(g1.y)); o1.z = pk2(hs[12] * bflo(g1.z), hs[13] * bfhi(g1.z)); o1.w = pk2(hs[14] * bflo(g1.w), hs[15] * bfhi(g1.w));
    *(u32x4*)(F.OB + ro) = o0; *(u32x4*)(F.OB + ro + 8) = o1;
}
__device__ __forceinline__ void rg_carry(const Fr& F) {
    const int lane = F.lane;
    for (int sq = F.bx * 8 + F.wave; sq < 3072; sq += F.G * 8) {
        const int z = sq / 1536, c = sq % 1536;
        float ap[5], he[5]; size_t off[5];
        float Pl = 1.f, Hl = 0.f;
#pragma unroll
        for (int i = 0; i < 5; ++i) { const int ss = 5 * lane + i; const bool ok = ss < NCH; const int sc = ok ? ss : 0, n = z ? (NCH - 1 - sc) : (sc < 4 ? 256 + sc : sc - 4);
            off[i] = (size_t)(z * NCH + n) * 1536 + c; ap[i] = ok ? F.AP[off[i]] : 1.f; he[i] = ok ? F.HE[off[i]] : 0.f; }
#pragma unroll
        for (int i = 0; i < 5; ++i) { Hl = ap[i] * Hl + he[i]; Pl *= ap[i]; }
        float Pi = Pl, Hi = Hl;
#pragma unroll
        for (int o = 1; o < 64; o <<= 1) {
            const int src = lane - o;
            const float Pp = __builtin_bit_cast(float, __builtin_amdgcn_ds_bpermute((src < 0 ? lane : src) << 2, __builtin_bit_cast(int, Pi)));
            const float Hp = __builtin_bit_cast(float, __builtin_amdgcn_ds_bpermute((src < 0 ? lane : src) << 2, __builtin_bit_cast(int, Hi)));
            if (src >= 0) { Hi = Pi * Hp + Hi; Pi = Pi * Pp; }
        }
        float hh = __builtin_bit_cast(float, __builtin_amdgcn_ds_bpermute((lane > 0 ? lane - 1 : 0) << 2, __builtin_bit_cast(int, Hi)));
        if (lane == 0) hh = 0.f;
#pragma unroll
        for (int i = 0; i < 5; ++i) { if (5 * lane + i < NCH) F.CIN[off[i]] = hh; hh = ap[i] * hh + he[i]; }
    }
}

__device__ __forceinline__ void swa_unit(const Fr& F, int qb, int kvh) {
    LAS unsigned char* lds = F.lds;
    LAS bf16* sK = (LAS bf16*)(lds);
    LAS bf16* sVT = (LAS bf16*)(lds + 9216);
    const int tid = F.tid, row0 = 64 * qb, r = F.lane & 15, q = F.lane >> 4, w = F.wave;
    const bool is_ctx = qb >= 256;
    const int hq = kvh * 4 + (w >> 1), qoff = 32 * (w & 1);
    bf16x8 bq[2][2];
#pragma unroll
    for (int qt = 0; qt < 2; ++qt)
#pragma unroll
        for (int ks = 0; ks < 2; ++ks) bq[qt][ks] = *(const bf16x8*)(F.QKV + (size_t)(row0 + qoff + 16 * qt + r) * 1536 + hq * 64 + 32 * ks + 8 * q);
    float mrun[2], lrun[2];
    f32x4 o[4][2];
    { const float sk = F.swa_sink[hq]; mrun[0] = sk; mrun[1] = sk; lrun[0] = (q == 0) ? 1.f : 0.f; lrun[1] = lrun[0]; }
#pragma unroll
    for (int dt = 0; dt < 4; ++dt) { o[dt][0] = (f32x4){0.f, 0.f, 0.f, 0.f}; o[dt][1] = (f32x4){0.f, 0.f, 0.f, 0.f}; }
    const int ntiles = is_ctx ? 4 : 9;
#pragma unroll 1
    for (int ti = 0; ti < ntiles; ++ti) {
        int krow0; bool local;
        if (ti < 4) { krow0 = SEQ + 64 * ti; local = false; }
        else { krow0 = row0 - 128 + 64 * (ti - 4); local = true; if (krow0 < 0 || krow0 >= SEQ) continue; }
        __syncthreads();
        {
            const int key = tid >> 3, d0 = (tid & 7) * 8;
            const bf16* kp = F.QKV + (size_t)(krow0 + key) * 1536 + 1024 + kvh * 64 + d0;
            *(LAS bf16x8*)(sK + key * 72 + d0) = *(const bf16x8*)kp;
            const bf16x8 vv = *(const bf16x8*)(kp + 256);
#pragma unroll
            for (int i = 0; i < 8; ++i) sVT[(d0 + i) * 72 + key] = (unsigned short)vv[i];
        }
        __syncthreads();
        f32x4 st[4][2];
#pragma unroll
        for (int kt = 0; kt < 4; ++kt) {
            const bf16x8 a0 = *(const LAS bf16x8*)(sK + (16 * kt + r) * 72 + 8 * q), a1 = *(const LAS bf16x8*)(sK + (16 * kt + r) * 72 + 32 + 8 * q);
#pragma unroll
            for (int qt = 0; qt < 2; ++qt) { f32x4 a = {0.f, 0.f, 0.f, 0.f}; a = mma(a0, bq[qt][0], a); a = mma(a1, bq[qt][1], a); st[kt][qt] = a; }
        }
        if (local) {
#pragma unroll
            for (int kt = 0; kt < 4; ++kt)
#pragma unroll
                for (int qt = 0; qt < 2; ++qt)
#pragma unroll
                    for (int jj = 0; jj < 4; ++jj) { const int kpos = krow0 + 16 * kt + 4 * q + jj, qpos = row0 + qoff + 16 * qt + r; const int dd = kpos - qpos; if (dd > 128 || dd < -128) st[kt][qt][jj] = -1e30f; }
        }
#pragma unroll
        for (int qt = 0; qt < 2; ++qt) {
            float tm = -1e30f;
#pragma unroll
            for (int kt = 0; kt < 4; ++kt)
#pragma unroll
                for (int jj = 0; jj < 4; ++jj) tm = fmaxf(tm, st[kt][qt][jj]);
            tm = fmaxf(tm, shx(tm, 16, F.lane)); tm = fmaxf(tm, shx(tm, 32, F.lane));
            const float mn = fmaxf(mrun[qt], tm), alpha = __expf(mrun[qt] - mn);
            mrun[qt] = mn; float ls = lrun[qt] * alpha;
#pragma unroll
            for (int dt = 0; dt < 4; ++dt) o[dt][qt] *= alpha;
#pragma unroll
            for (int kt = 0; kt < 4; ++kt)
#pragma unroll
                for (int jj = 0; jj < 4; ++jj) { const float p = __expf(st[kt][qt][jj] - mn); ls += p; st[kt][qt][jj] = p; }
            lrun[qt] = ls;
        }
#pragma unroll
        for (int kp = 0; kp < 2; ++kp) {
            bf16x8 bp[2];
#pragma unroll
            for (int qt = 0; qt < 2; ++qt) {
                u32x4 pw; pw.x = pk2(st[2 * kp][qt][0], st[2 * kp][qt][1]); pw.y = pk2(st[2 * kp][qt][2], st[2 * kp][qt][3]);
                pw.z = pk2(st[2 * kp + 1][qt][0], st[2 * kp + 1][qt][1]); pw.w = pk2(st[2 * kp + 1][qt][2], st[2 * kp + 1][qt][3]);
                bp[qt] = __builtin_bit_cast(bf16x8, pw);
            }
#pragma unroll
            for (int dt = 0; dt < 4; ++dt) {
                const u32x2 v0 = *(const LAS u32x2*)(sVT + (16 * dt + r) * 72 + 32 * kp + 4 * q), v1 = *(const LAS u32x2*)(sVT + (16 * dt + r) * 72 + 32 * kp + 16 + 4 * q);
                u32x4 vw; vw.x = v0.x; vw.y = v0.y; vw.z = v1.x; vw.w = v1.y;
                const bf16x8 av = __builtin_bit_cast(bf16x8, vw);
                o[dt][0] = mma(av, bp[0], o[dt][0]); o[dt][1] = mma(av, bp[1], o[dt][1]);
            }
        }
    }
#pragma unroll
    for (int qt = 0; qt < 2; ++qt) {
        float lt = lrun[qt]; lt += shx(lt, 16, F.lane); lt += shx(lt, 32, F.lane);
        const float inv = __builtin_amdgcn_rcpf(lt);
        bf16* op = F.OB + (size_t)(row0 + qoff + 16 * qt + r) * 1024 + hq * 64 + 4 * q;
#pragma unroll
        for (int dt = 0; dt < 4; ++dt) { const f32x4 v = o[dt][qt] * inv; u32x2 ow; ow.x = pk2(v[0], v[1]); ow.y = pk2(v[2], v[3]); *(u32x2*)(op + 16 * dt) = ow; }
    }
    __syncthreads();
}


#define CAS __attribute__((address_space(4)))
__device__ __forceinline__ const float* ld_in(const CAS unsigned char* kargp, int k) { asm volatile("" : "+s"(k)); return *(const float* const CAS*)(kargp + (size_t)k * 8); }
__device__ __forceinline__ unsigned char* ws_at(unsigned char* ws, unsigned long long off) { asm volatile("" : "+s"(off)); return ws + off; }
__device__ __forceinline__ void fill_ptrs(Fr& F, const CAS unsigned char* kargp) {
    F.x = ld_in(kargp, 0); F.c = ld_in(kargp, 1); F.ctx = ld_in(kargp, 2); F.c_ctx = ld_in(kargp, 3); F.ada_w = ld_in(kargp, 4); F.ada_b = ld_in(kargp, 5); F.norm_g = ld_in(kargp, 6); F.final_g = ld_in(kargp, 7);
    F.ffn_w_in = ld_in(kargp, 8); F.ffn_w_out = ld_in(kargp, 9); F.gla_w_in = ld_in(kargp, 10); F.gla_w_a2 = ld_in(kargp, 11); F.gla_b_a = ld_in(kargp, 12); F.gla_norm_g = ld_in(kargp, 13); F.gla_w_out = ld_in(kargp, 14);
    F.rg_w_in = ld_in(kargp, 15); F.rg_conv_w = ld_in(kargp, 16); F.rg_conv_b = ld_in(kargp, 17); F.rg_w_a = ld_in(kargp, 18); F.rg_b_a = ld_in(kargp, 19); F.rg_w_x = ld_in(kargp, 20); F.rg_b_x = ld_in(kargp, 21);
    F.rg_lam = ld_in(kargp, 22); F.rg_w_out = ld_in(kargp, 23); F.swa_w_qkv = ld_in(kargp, 24); F.swa_sink = ld_in(kargp, 25); F.swa_w_out = ld_in(kargp, 26);
    F.out = (float*)ld_in(kargp, 27); unsigned char* ws = (unsigned char*)ld_in(kargp, 28); F.ws = ws;
    F.MOD = (float*)ws_at(ws, WS_MOD); F.ROPE = (float*)ws_at(ws, WS_ROPE); F.X = (float*)ws_at(ws, WS_X);
    F.WFI = (bf16*)ws_at(ws, WS_WFI); F.WFO = (bf16*)ws_at(ws, WS_WFO); F.WGI = (bf16*)ws_at(ws, WS_WGI); F.WGO = (bf16*)ws_at(ws, WS_WGO); F.WRI = (bf16*)ws_at(ws, WS_WRI); F.WRO = (bf16*)ws_at(ws, WS_WRO);
    F.WRA = (bf16*)ws_at(ws, WS_WRA); F.WRX = (bf16*)ws_at(ws, WS_WRX); F.WSQ = (bf16*)ws_at(ws, WS_WSQ); F.WSO = (bf16*)ws_at(ws, WS_WSO);
    F.XN = (bf16*)ws_at(ws, WS_XN); F.OB = (bf16*)ws_at(ws, WS_OB); F.H = (bf16*)ws_at(ws, WS_AR + A_H);
    F.P = (bf16*)ws_at(ws, WS_AR + A_P); F.LR = (float*)ws_at(ws, WS_AR + A_LR); F.QD = (bf16*)ws_at(ws, WS_AR + A_QD); F.KN = (bf16*)ws_at(ws, WS_AR + A_KN); F.DEC = (float*)ws_at(ws, WS_AR + A_DEC); F.US = (bf16*)ws_at(ws, WS_AR + A_US);
    F.GG = (bf16*)ws_at(ws, WS_AR + A_GG); F.XR = (bf16*)ws_at(ws, WS_AR + A_XR); F.AP = (float*)ws_at(ws, WS_AR + A_AP); F.HE = (float*)ws_at(ws, WS_AR + A_HE); F.CIN = (float*)ws_at(ws, WS_AR + A_CIN); F.LAg = (bf16*)ws_at(ws, WS_AR + A_LA); F.UUg = (bf16*)ws_at(ws, WS_AR + A_UU);
    F.QKV = (bf16*)ws_at(ws, WS_AR + A_QKV); F.SLAB = (float*)ws_at(ws, WS_SLAB);
}

#ifdef DBG_CHECK
__device__ __forceinline__ bool bad16(unsigned short u) { return (u & 0x7f80u) == 0x7f80u; }
__device__ __forceinline__ bool bad32(unsigned u) { return (u & 0x7f800000u) == 0x7f800000u; }
__device__ __forceinline__ void dbg_scan(const Fr& F, unsigned* flag) {
    const size_t gt = (size_t)F.bx * 512 + F.tid, NGT = (size_t)F.G * 512;
    unsigned m = 0;
    for (size_t i = gt; i < (size_t)MT * 32; i += NGT) if (bad32(((const unsigned*)F.LR)[i])) m |= 1u;
    for (size_t i = gt; i < (size_t)MT * 3072; i += NGT) if (bad16(F.P[i])) m |= 2u;
    for (size_t i = gt; i < (size_t)2 * MT * 512; i += NGT) { if (bad16(F.QD[i])) m |= 4u; if (bad16(F.KN[i])) m |= 8u; }
    for (size_t i = gt; i < (size_t)2 * NCH * 4 * 32768; i += NGT) if (bad16(F.US[i])) m |= 16u;
    for (size_t i = gt; i < (size_t)MT * 1024; i += NGT) if (bad16(F.OB[i])) m |= 32u;
    if (m) atomicOr(flag, m);
}
#endif

#define XB_TMO      128
#define XB_XCNT(j)  (256  + 64 * (j))
#define XB_XSUB(j)  (1280 + 64 * (j))
#define XB_XGEN(j)  (2304 + 64 * (j))
#define XB_TOP      3328
#define XB_TOPGEN   3392
#define XCD_BAR_WORDS 3456
#define XB_SPIN_CAP (1u << 18)

__device__ __forceinline__ unsigned xb_ld(unsigned* p)              { return __hip_atomic_load(p, __ATOMIC_RELAXED, __HIP_MEMORY_SCOPE_AGENT); }
__device__ __forceinline__ unsigned xb_add(unsigned* p, unsigned v) { return __hip_atomic_fetch_add(p, v, __ATOMIC_RELAXED, __HIP_MEMORY_SCOPE_AGENT); }
__device__ __forceinline__ unsigned xb_xcc_id() { return (unsigned)__builtin_amdgcn_s_getreg((3 << 11) | 20) & 0xFu; }
#define XB_SPIN(cond, bar) do { unsigned _sp = 0; while (cond) { __builtin_amdgcn_s_sleep(1); \
    if ((++_sp & 255u) == 0u) { if (xb_ld(&(bar)[XB_TMO])) break; if (_sp > XB_SPIN_CAP) { atomicAdd(&(bar)[XB_TMO], 1u); break; } } } } while (0)

struct XcdBarrier {
    unsigned* bar; unsigned x;
    volatile LAS unsigned* st;
};

__device__ __forceinline__ XcdBarrier xcd_barrier_post(unsigned* bar, volatile LAS unsigned* st) {
    XcdBarrier b; b.bar = bar; b.x = xb_xcc_id(); b.st = st;
    if (threadIdx.x == 0) (void)xb_add(&bar[XB_XCNT(b.x)], 1u);
    return b;
}
__device__ __forceinline__ void xcd_barrier_complete(unsigned* bar, unsigned x, unsigned& nloc, unsigned& nx) {
    const unsigned G = gridDim.x * gridDim.y * gridDim.z;
    unsigned sum, cnt, mine, sp = 0u;
    for (;;) {
        sum = 0u; cnt = 0u; mine = 0u;
#pragma unroll
        for (unsigned j = 0; j < 16; ++j) { const unsigned c = xb_ld(&bar[XB_XCNT(j)]); sum += c; cnt += (c > 0u) ? 1u : 0u; mine = (j == x) ? c : mine; }
        if (sum == G) break;
        __builtin_amdgcn_s_sleep(1);
        if ((++sp & 255u) == 0u) { if (xb_ld(&bar[XB_TMO])) break; if (sp > XB_SPIN_CAP) { atomicAdd(&bar[XB_TMO], 1u); break; } }
    }
    nloc = mine > 0u ? mine : 1u; nx = cnt > 0u ? cnt : 1u;
}

__device__ __forceinline__ void xcd_barrier(const XcdBarrier& b) {
    asm volatile("s_waitcnt vmcnt(0)" ::: "memory");
    __syncthreads();
    if (threadIdx.x == 0) {
        unsigned* bar = b.bar;
        __builtin_amdgcn_s_waitcnt(0);
        unsigned nloc = b.st[0], nx = b.st[1];
        if (nloc == 0u) { xcd_barrier_complete(bar, b.x, nloc, nx); b.st[0] = nloc; b.st[1] = nx; }
        const unsigned old = xb_add(&bar[XB_XSUB(b.x)], 1u);
        const unsigned gen = old / nloc;
        if (old + 1u == (gen + 1u) * nloc) {
            __builtin_amdgcn_fence(__ATOMIC_RELEASE, "agent");
            asm volatile("s_waitcnt vmcnt(0)" ::: "memory");
            const unsigned og = xb_add(&bar[XB_TOP], 1u);
            const unsigned tg = og / nx;
            if (og + 1u == (tg + 1u) * nx) xb_add(&bar[XB_TOPGEN], 1u);
            else XB_SPIN(xb_ld(&bar[XB_TOPGEN]) == tg, bar);
            __builtin_amdgcn_fence(__ATOMIC_ACQUIRE, "agent");
            xb_add(&bar[XB_XGEN(b.x)], 1u);
            asm volatile("s_waitcnt vmcnt(0)" ::: "memory");
        } else {
            XB_SPIN(xb_ld(&bar[XB_XGEN(b.x)]) == gen, bar);
            __builtin_amdgcn_fence(__ATOMIC_ACQUIRE, "agent");
            asm volatile("s_waitcnt vmcnt(0)" ::: "memory");
        }
    }
    __syncthreads();
}


__global__ void __launch_bounds__(512) fwd_megakernel(Args args) {
    extern __shared__ __attribute__((aligned(16))) unsigned char lds_raw[];
    cg::grid_group grid = cg::this_grid();
    Fr B0;
    B0.lds = (LAS unsigned char*)lds_raw; B0.tid = 0; B0.lane = 0; B0.wave = __builtin_amdgcn_readfirstlane(threadIdx.x >> 6); B0.G = gridDim.x; B0.bx = blockIdx.x;
    const CAS unsigned char* kargp = (const CAS unsigned char*)__builtin_amdgcn_kernarg_segment_ptr();
    if (threadIdx.x < 16) ((LAS unsigned*)(B0.lds + LDS_MISC))[threadIdx.x] = 0u;
    __syncthreads();
    const XcdBarrier bar = xcd_barrier_post((unsigned*)(args.ws + WS_BAR), (volatile LAS unsigned*)(B0.lds + LDS_MISC));
    const int lo = args.ph_lo, hi = args.ph_hi;
    if (hi < 0) grid.sync();
    int ph = 0;
#define PH_BEGIN_G(g) if (ph >= lo && ph < hi) for (int rep_ = 0; rep_ < (int)((DUP_MASK >> (g)) & 1) + 1; ++rep_) { Fr F = B0; { unsigned m1_ = ~0u; asm volatile("" : "+s"(m1_)); F.lane = (int)__builtin_amdgcn_mbcnt_hi(m1_, __builtin_amdgcn_mbcnt_lo(m1_, 0u)); } asm volatile("" : "+s"(F.G)); asm volatile("" : "+s"(F.bx)); asm volatile("" : "+s"(F.wave)); F.tid = F.wave * 64 + F.lane; fill_ptrs(F, kargp);
#define PH_END xcd_barrier(bar); } ++ph;

    PH_BEGIN_G(0)
#ifndef NO_PRO
 ph_prologue(F);
#endif
 PH_END

#pragma unroll 1
    for (int layer = 0; layer < DEPTH; ++layer) {
        const int mix = layer % 3, j = layer / 3; const bool last = (layer == DEPTH - 1);
        PH_BEGIN_G(1) ph_norm(F, layer, 0, MT, layer == 0 ? 0 : DFF / 256); PH_END
        PH_BEGIN_G(2) { EpiSwiglu E{F.H}; run_gemm(F, F.XN, F.WFI + (size_t)(layer * 2 + 0) * 2 * DFF * D, MT, 2 * DFF, D, E); } PH_END
        PH_BEGIN_G(3) run_resid_gemm(F, F.H, F.WFO + (size_t)(layer * 2 + 0) * D * DFF, DFF, true, F.MOD + (size_t)layer * 2 * NMODV, 2, rep_ == (int)((DUP_MASK >> 3) & 1) ? 0.5f : 0.0f); PH_END
        PH_BEGIN_G(1) ph_norm(F, layer, 1, MT, DFF / 256); PH_END
        const int Mact = last ? SEQ : MT;
        if (mix == 0) {
            PH_BEGIN_G(4) { EpiGlaIn E{F.P, F.LR}; run_gemm(F, F.XN, F.WGI + (size_t)j * GLA_NP * D, MT, GLA_NP, D, E); } PH_END
            PH_BEGIN_G(6)
#ifndef NO_GLAB
 for (int u = ((F.G & 7) == 0 ? (F.bx & 7) * (F.G >> 3) + (F.bx >> 3) : F.bx); u < NCH * 8; u += F.G) gla_b_unit(F, j, u >> 3, (u >> 1) & 3, u & 1);
#endif
 PH_END
            PH_BEGIN_G(31)
#ifndef NO_GLAC
 gla_scan(F);
#endif
 PH_END
            PH_BEGIN_G(7)
#ifndef NO_GLAD
 { const int nu = (last ? 256 : NCH) * 4; for (int u = ((F.G & 7) == 0 ? (F.bx & 7) * (F.G >> 3) + (F.bx >> 3) : F.bx); u < nu; u += F.G) gla_d_unit(F, j, u >> 2, u & 3); }
#endif
 PH_END
            PH_BEGIN_G(5) run_resid_gemm(F, F.OB, F.WGO + (size_t)j * D * D, D, !last, F.MOD + (size_t)layer * 2 * NMODV, 5, rep_ == (int)((DUP_MASK >> 5) & 1) ? 1.0f : 0.0f); PH_END
        } else if (mix == 1) {
            PH_BEGIN_G(4) { EpiRgIn E{F.GG, F.XR}; run_gemm(F, F.XN, F.WRI, MT, 3072, D, E); } PH_END
            PH_BEGIN_G(8)
#ifndef NO_RG
 { int it_ = 0; for (int u = F.bx; u < NCH * 12; u += F.G, ++it_) rg_unit(F, u / 12, u % 12, 0, it_ & 1); __syncthreads(); }
#endif
 PH_END
            PH_BEGIN_G(9) rg_carry(F); PH_END
            PH_BEGIN_G(11)
#ifndef NO_RG
 for (int u = F.bx; u < NCH * 12; u += F.G) rg_unit1(F, u / 12, u % 12);
#endif
 PH_END
            PH_BEGIN_G(5) run_resid_gemm(F, F.OB, F.WRO, 1536, !last, F.MOD + (size_t)layer * 2 * NMODV, 5, rep_ == (int)((DUP_MASK >> 5) & 1) ? 1.0f : 0.0f); PH_END
        } else {
            PH_BEGIN_G(4) { EpiSwaQkv E{F.QKV, F.ROPE}; run_gemm(F, F.XN, F.WSQ, MT, 1536, D, E); } PH_END
            PH_BEGIN_G(10)
#ifndef NO_SWA
 for (int u = ((F.G & 7) == 0 ? (F.bx & 7) * (F.G >> 3) + (F.bx >> 3) : F.bx); u < NCH * 4; u += F.G) swa_unit(F, u >> 2, u & 3);
#endif
 PH_END
            PH_BEGIN_G(5) run_resid_gemm(F, F.OB, F.WSO, D, !last, F.MOD + (size_t)layer * 2 * NMODV, 5, rep_ == (int)((DUP_MASK >> 5) & 1) ? 1.0f : 0.0f); PH_END
        }
        PH_BEGIN_G(1) ph_norm(F, layer, 2, Mact, mix == 1 ? 1536 / 256 : D / 256); PH_END
        PH_BEGIN_G(2) { EpiSwiglu E{F.H}; run_gemm(F, F.XN, F.WFI + (size_t)(layer * 2 + 1) * 2 * DFF * D, Mact, 2 * DFF, D, E); } PH_END
        PH_BEGIN_G(3) run_resid_gemm(F, F.H, F.WFO + (size_t)(layer * 2 + 1) * D * DFF, DFF, !last, F.MOD + (size_t)layer * 2 * NMODV, 8, rep_ == (int)((DUP_MASK >> 3) & 1) ? 0.5f : 0.0f); PH_END
    }
#ifdef DBG_CHECK
    { Fr F = B0; { unsigned m1_ = ~0u; asm volatile("" : "+s"(m1_)); F.lane = (int)__builtin_amdgcn_mbcnt_hi(m1_, __builtin_amdgcn_mbcnt_lo(m1_, 0u)); } asm volatile("" : "+s"(F.G)); asm volatile("" : "+s"(F.bx)); asm volatile("" : "+s"(F.wave)); F.tid = F.wave * 64 + F.lane; fill_ptrs(F, kargp);
      unsigned* flag = (unsigned*)(F.ws + 512 * 1024);
      dbg_scan(F, flag);
      for (size_t i = (size_t)F.bx * 512 + F.tid; i < (size_t)SEQ * D; i += (size_t)F.G * 512) F.out[i] = 0.f;
      xcd_barrier(bar);
      if (F.bx == 0 && F.tid == 0) F.out[0] = 1000.0f * (float)(__hip_atomic_load(flag, __ATOMIC_RELAXED, __HIP_MEMORY_SCOPE_AGENT) + 1u);
    }
#else
    { Fr F = B0; { unsigned m1_ = ~0u; asm volatile("" : "+s"(m1_)); F.lane = (int)__builtin_amdgcn_mbcnt_hi(m1_, __builtin_amdgcn_mbcnt_lo(m1_, 0u)); } asm volatile("" : "+s"(F.G)); asm volatile("" : "+s"(F.bx)); asm volatile("" : "+s"(F.wave)); F.tid = F.wave * 64 + F.lane; fill_ptrs(F, kargp); ph_final(F); }
#endif
}

extern "C" void kernel_launch(void* const* d_in, const int* in_sizes, int n_in, void* d_out, int out_size, void* d_ws, size_t ws_size, hipStream_t stream) {
    static int grid = 0;
    if (grid == 0) {
        if (n_in != 27 || out_size != SEQ * D || ws_size < WS_END) { fprintf(stderr, "kernel_launch: unexpected shapes (n_in %d out %d ws %zu)\n", n_in, out_size, ws_size); grid = -1; return; }
        int dev = 0, cus = 0, per_cu = 0;
        hipGetDevice(&dev);
        hipDeviceGetAttribute(&cus, hipDeviceAttributeMultiprocessorCount, dev);
        hipFuncSetAttribute((const void*)fwd_megakernel, hipFuncAttributeMaxDynamicSharedMemorySize, LDS_BYTES);
        hipOccupancyMaxActiveBlocksPerMultiprocessor(&per_cu, (const void*)fwd_megakernel, 512, LDS_BYTES);
        if (per_cu < 1) { fprintf(stderr, "kernel_launch: occupancy query says %d blocks per CU\n", per_cu); per_cu = 1; }
        (void)hipGetLastError();
        grid = cus * 1;
        fprintf(stderr, "kernel_launch: grid %d (cus %d, per_cu %d)\n", grid, cus, per_cu);
    }
    if (grid < 0) return;
    if (hipMemsetAsync((char*)d_ws + WS_BAR, 0, BAR_BYTES, stream) != hipSuccess) { fprintf(stderr, "kernel_launch: memset failed\n"); return; }
    Args a{};
    for (int i = 0; i < 27; ++i) a.in[i] = (const float*)d_in[i];
    a.out = (float*)d_out; a.ws = (unsigned char*)d_ws; a.ph_lo = 0; a.ph_hi = PH_LIMIT;
    void* kargs[] = {&a};
    hipError_t e = hipLaunchCooperativeKernel((const void*)fwd_megakernel, dim3(grid), dim3(512), kargs, LDS_BYTES, stream);
    if (e != hipSuccess) fprintf(stderr, "cooperative launch failed: %s (grid %d)\n", hipGetErrorString(e), grid);
}
```

```cpp
#include <hip/hip_runtime.h>
#include <hip/hip_cooperative_groups.h>
#include <cstdio>
#include <cstdint>
namespace cg = cooperative_groups;
namespace pg8 {
#define PG8_LAS __attribute__((address_space(3)))
typedef unsigned short bf16_t;
typedef short bf16x8 __attribute__((ext_vector_type(8)));
typedef float f32x4 __attribute__((ext_vector_type(4)));
typedef unsigned u32x4 __attribute__((ext_vector_type(4)));
constexpr int BM = 256, BK = 64, HALF = 128, HTB = HALF * BK * 2  , STAGE_BYTES = 8 * HTB, NXCD = 8, WGM = 8;

__host__ __device__ __forceinline__ int lds_byte(int r, int c) { const int st = (r >> 4) * 2 + (c >> 5), rr = r & 15, cc = c & 31, ob = rr * 64 + cc * 2; return st * 1024 + (ob ^ (((ob >> 9) & 1) << 5)); }
__host__ __device__ __forceinline__ void stage_rc(int b, int& R, int& C) { const int st = b / 1024, sb = b % 1024, swz = sb ^ (((sb >> 9) & 1) << 5); R = (st >> 1) * 16 + swz / 64; C = (st & 1) * 32 + (swz % 64) / 2; }
__host__ __device__ __forceinline__ int perm32(int rho) { const int n = rho >> 4, i = rho & 15; return 8 * (i >> 2) + 4 * n + (i & 3); }

struct Unit { int pm, pn, ks; };
struct Gemm { const bf16_t* A; const bf16_t* Bt; int M, N, K, KS; };

struct StaticOrder {
    int nM, nN, nwg, G, c;
    __host__ __device__ void init(int M, int N, int G_, int c_) { nM = M / BM; nN = N / BM; nwg = nM * nN; G = G_; c = c_; }
    __host__ __device__ bool next(int i, Unit& u) const {
        const long L = (long)i * G + c; if (L >= nwg) return false;
        int wgid = (int)L; { const int q = nwg / NXCD, r = nwg % NXCD, xcd = wgid % NXCD, off = wgid / NXCD; wgid = (xcd < r ? xcd * (q + 1) : r * (q + 1) + (xcd - r) * q) + off; }
        const int nig = WGM * nN, gid = wgid / nig, fm = gid * WGM, gsz = (nM - fm) < WGM ? (nM - fm) : WGM;
        u.pm = fm + ((wgid % nig) % gsz); u.pn = (wgid % nig) / gsz; u.ks = 0; return true;
    }
    __device__ __forceinline__ void a_ready(const Unit&) const {}
    __device__ __forceinline__ void done(const Unit&) const {}
};
struct SplitKOrder {
    int pm, nN, nks, G, c;
    __host__ __device__ bool next(int i, Unit& u) const { const int L = i * G + c; if (L >= nN * nks) return false; u.pm = pm; u.pn = L % nN; u.ks = L / nN; return true; }
    __device__ __forceinline__ void a_ready(const Unit&) const {}
    __device__ __forceinline__ void done(const Unit&) const {}
};
__device__ __forceinline__ unsigned cvt_pk_bf16(float lo, float hi) { unsigned r; asm volatile("v_cvt_pk_bf16_f32 %0, %1, %2" : "=v"(r) : "v"(lo), "v"(hi)); return r; }
template <class Epi, class Sched, bool ALIGN_EPI = false, bool SP2 = false>
__device__ __forceinline__ void gemm_phase(PG8_LAS unsigned char* lds, const Gemm g, const Sched& S, const Epi& E, const int tid_in) {
    const int tid = tid_in, wid = __builtin_amdgcn_readfirstlane(tid >> 6), lane = tid & 63, wr = wid >> 2, wc = wid & 3, fr = lane & 15, fq = lane >> 4;
    const int K = g.K, nt = g.KS / BK; const size_t ksb = (size_t)g.KS * 2;
    unsigned voffA[2], voffB[2];
#pragma unroll
    for (int i = 0; i < 2; ++i) { int R, C; stage_rc(tid * 16 + i * 8192, R, C); const int Rb = Epi::PERM ? ((R & ~31) + perm32(R & 31)) : R;
        voffA[i] = (unsigned)(R * K + C) * 2u; voffB[i] = (unsigned)(Rb * K + C) * 2u; }
    const size_t kstep = (size_t)(BK * 2);
    const size_t hstep = (size_t)HALF * K * 2;
    const size_t tstep = 2 * hstep;
    const unsigned ldsw = (unsigned)wid * 1024u;
    const int aoff = lds_byte(wr * 64 + fr, fq * 8), boff = lds_byte(wc * 32 + fr, fq * 8);
#define PG8_SA(b, h) (((b) * 2 + (h)) * HTB)
#define PG8_SB(b, h) ((4 + (b) * 2 + (h)) * HTB)
#define PG8_STAGE(bufoff, gbase, voff) do { _Pragma("unroll") for (int _i = 0; _i < 2; ++_i) \
        __builtin_amdgcn_global_load_lds((const unsigned*)((const char*)(gbase) + (voff)[_i]), (PG8_LAS unsigned*)(lds + (bufoff) + ldsw + _i * 8192), 16, 0, 0); } while (0)
#define PG8_LDA(dst, b, h) do { _Pragma("unroll") for (int m = 0; m < 4; ++m) _Pragma("unroll") for (int k = 0; k < 2; ++k) dst[m][k] = *(const PG8_LAS bf16x8*)(lds + PG8_SA(b, h) + aoff + m * 2048 + k * 1024); } while (0)
#define PG8_LDB(dst, b, h) do { _Pragma("unroll") for (int n = 0; n < 2; ++n) _Pragma("unroll") for (int k = 0; k < 2; ++k) dst[n][k] = *(const PG8_LAS bf16x8*)(lds + PG8_SB(b, h) + boff + n * 2048 + k * 1024); } while (0)
#define PG8_MMA(ai, bj, At, Bt) do { __builtin_amdgcn_s_setprio(1); _Pragma("unroll") for (int m = 0; m < 4; ++m) _Pragma("unroll") for (int n = 0; n < 2; ++n) _Pragma("unroll") for (int k = 0; k < 2; ++k) \
        acc[ai][bj][m][n] = __builtin_amdgcn_mfma_f32_16x16x32_bf16(Bt[n][k], At[m][k], acc[ai][bj][m][n], 0, 0, 0); __builtin_amdgcn_s_setprio(0); } while (0)
#define PG8_WAIT_V(n) asm volatile("s_waitcnt vmcnt(" #n ")" ::: "memory")
#define PG8_WAIT_L(n) asm volatile("s_waitcnt lgkmcnt(" #n ")" ::: "memory")
#define PG8_BAR __builtin_amdgcn_s_barrier()
#define PG8_SCHED __builtin_amdgcn_sched_barrier(0)
    Unit cur, nxt; int ui = 0;
    if (!S.next(0, cur)) return;
    f32x4 acc[2][2][4][2];
#pragma unroll
    for (int a = 0; a < 2; ++a)
#pragma unroll
        for (int b = 0; b < 2; ++b)
#pragma unroll
            for (int m = 0; m < 4; ++m)
#pragma unroll
                for (int n = 0; n < 2; ++n) acc[a][b][m][n] = (f32x4){0.f, 0.f, 0.f, 0.f};
    bf16x8 At[4][2], B0[2][2], B1[2][2];
    const char* cA = (const char*)g.A + (size_t)cur.pm * tstep + (size_t)cur.ks * ksb; const char* cB = (const char*)g.Bt + (size_t)cur.pn * tstep + (size_t)cur.ks * ksb;
    S.a_ready(cur);
    if constexpr (SP2) {
        PG8_STAGE(PG8_SB(0, 0), cB, voffB); PG8_STAGE(PG8_SB(0, 1), cB + hstep, voffB); PG8_STAGE(PG8_SA(0, 0), cA, voffA); PG8_STAGE(PG8_SA(0, 1), cA + hstep, voffA);
        if (wr == 1) PG8_BAR;
        PG8_WAIT_V(2); PG8_BAR;
        PG8_STAGE(PG8_SB(1, 0), cB + kstep, voffB); PG8_STAGE(PG8_SA(1, 0), cA + kstep, voffA); PG8_STAGE(PG8_SB(1, 1), cB + hstep + kstep, voffB);
        PG8_WAIT_V(6); PG8_BAR;
    } else {
        PG8_STAGE(PG8_SB(0, 0), cB, voffB); PG8_STAGE(PG8_SA(0, 0), cA, voffA); PG8_STAGE(PG8_SB(0, 1), cB + hstep, voffB); PG8_STAGE(PG8_SA(0, 1), cA + hstep, voffA);
        if (wr == 1) PG8_BAR;
        PG8_WAIT_V(4); PG8_BAR;
        PG8_STAGE(PG8_SB(1, 0), cB + kstep, voffB); PG8_STAGE(PG8_SA(1, 0), cA + kstep, voffA); PG8_STAGE(PG8_SB(1, 1), cB + hstep + kstep, voffB);
        PG8_WAIT_V(6); PG8_BAR;
    }
    for (;;) {
        const bool has_next = S.next(ui + 1, nxt);
        const char* nA = has_next ? (const char*)g.A + (size_t)nxt.pm * tstep + (size_t)nxt.ks * ksb : cA; const char* nB = has_next ? (const char*)g.Bt + (size_t)nxt.pn * tstep + (size_t)nxt.ks * ksb : cB;
        for (int t = 0; t < nt; t += 2) {
            const bool last = (t == nt - 2);
            const char* a1 = cA + (size_t)(t + 1) * kstep;
            const char* a2 = last ? nA : cA + (size_t)(t + 2) * kstep; const char* b2 = last ? nB : cB + (size_t)(t + 2) * kstep;
            const char* a3 = a2 + kstep; const char* b3 = b2 + kstep;
            if (last && has_next) S.a_ready(nxt);
            if constexpr (SP2) {
            PG8_LDB(B0, 0, 0); PG8_LDB(B1, 0, 1); PG8_SCHED; PG8_LDA(At, 0, 0); PG8_STAGE(PG8_SA(1, 1), a1 + hstep, voffA);
            PG8_WAIT_V(8); PG8_WAIT_L(0); PG8_BAR; PG8_MMA(0, 0, At, B0); PG8_MMA(0, 1, At, B1); PG8_BAR; PG8_SCHED;
            PG8_LDA(At, 0, 1); PG8_STAGE(PG8_SB(0, 0), b2, voffB); PG8_STAGE(PG8_SB(0, 1), b2 + hstep, voffB); PG8_STAGE(PG8_SA(0, 0), a2, voffA);
            PG8_WAIT_V(8); PG8_WAIT_L(0); PG8_BAR; PG8_MMA(1, 0, At, B0); PG8_MMA(1, 1, At, B1); PG8_BAR; PG8_SCHED;
            PG8_LDB(B0, 1, 0); PG8_LDB(B1, 1, 1); PG8_SCHED; PG8_LDA(At, 1, 0); PG8_STAGE(PG8_SA(0, 1), a2 + hstep, voffA);
            PG8_WAIT_V(8); PG8_WAIT_L(0); PG8_BAR; PG8_MMA(0, 0, At, B0); PG8_MMA(0, 1, At, B1); PG8_BAR; PG8_SCHED;
            PG8_LDA(At, 1, 1); PG8_STAGE(PG8_SB(1, 0), b3, voffB); PG8_STAGE(PG8_SB(1, 1), b3 + hstep, voffB); PG8_STAGE(PG8_SA(1, 0), a3, voffA);
            PG8_WAIT_V(8); PG8_WAIT_L(0); PG8_BAR; PG8_MMA(1, 0, At, B0); PG8_MMA(1, 1, At, B1); PG8_BAR; PG8_SCHED;
            } else {
            PG8_LDB(B0, 0, 0); PG8_SCHED; PG8_LDA(At, 0, 0); PG8_STAGE(PG8_SA(1, 1), a1 + hstep, voffA);
            PG8_WAIT_L(8); PG8_BAR; PG8_WAIT_L(0); PG8_MMA(0, 0, At, B0); PG8_BAR; PG8_SCHED;
            PG8_LDB(B1, 0, 1); PG8_STAGE(PG8_SB(0, 0), b2, voffB);
            PG8_BAR; PG8_WAIT_L(0); PG8_MMA(0, 1, At, B1); PG8_BAR;
            PG8_LDA(At, 0, 1); PG8_STAGE(PG8_SA(0, 0), a2, voffA);
            PG8_BAR; PG8_WAIT_L(0); PG8_MMA(1, 0, At, B0); PG8_BAR; PG8_SCHED;
            PG8_STAGE(PG8_SB(0, 1), b2 + hstep, voffB);
            PG8_WAIT_V(6); PG8_BAR; PG8_MMA(1, 1, At, B1); PG8_BAR;
            PG8_LDB(B0, 1, 0); PG8_SCHED; PG8_LDA(At, 1, 0); PG8_STAGE(PG8_SA(0, 1), a2 + hstep, voffA);
            PG8_WAIT_L(8); PG8_BAR; PG8_WAIT_L(0); PG8_MMA(0, 0, At, B0); PG8_BAR; PG8_SCHED;
            PG8_LDB(B1, 1, 1); PG8_STAGE(PG8_SB(1, 0), b3, voffB);
            PG8_BAR; PG8_WAIT_L(0); PG8_MMA(0, 1, At, B1); PG8_BAR;
            PG8_LDA(At, 1, 1); PG8_STAGE(PG8_SA(1, 0), a3, voffA);
            PG8_BAR; PG8_WAIT_L(0); PG8_MMA(1, 0, At, B0); PG8_BAR; PG8_SCHED;
            PG8_STAGE(PG8_SB(1, 1), b3 + hstep, voffB);
            PG8_WAIT_V(6); PG8_BAR; PG8_MMA(1, 1, At, B1); PG8_BAR;
            }
        }
        if constexpr (ALIGN_EPI) { if (wr == 0) PG8_BAR; }
        if constexpr (!Epi::AFTER_DRAIN) { E(acc, cur, wr, wc, fr, fq); S.done(cur); }
        if (!has_next) break;
#pragma unroll
        for (int a = 0; a < 2; ++a)
#pragma unroll
            for (int b = 0; b < 2; ++b)
#pragma unroll
                for (int m = 0; m < 4; ++m)
#pragma unroll
                    for (int n = 0; n < 2; ++n) acc[a][b][m][n] = (f32x4){0.f, 0.f, 0.f, 0.f};
        cur = nxt; cA = nA; cB = nB; ++ui;
        if constexpr (ALIGN_EPI) { if (wr == 1) PG8_BAR; }
    }
    PG8_WAIT_V(0);
    if constexpr (!ALIGN_EPI) { if (wr == 0) PG8_BAR; }
    PG8_BAR;
    if constexpr (Epi::AFTER_DRAIN) { E.fused(acc, cur, wr, wc, fr, fq, lds, wid, lane); S.done(cur); }
#undef PG8_SA
#undef PG8_SB
#undef PG8_STAGE
#undef PG8_LDA
#undef PG8_LDB
#undef PG8_MMA
#undef PG8_WAIT_V
#undef PG8_WAIT_L
#undef PG8_BAR
#undef PG8_SCHED
}
}

#define LAS __attribute__((address_space(3)))
typedef unsigned short bf16;
typedef short bf16x8 __attribute__((ext_vector_type(8)));
typedef short bf16x4 __attribute__((ext_vector_type(4)));
typedef float f32x4 __attribute__((ext_vector_type(4)));
typedef float f32x2 __attribute__((ext_vector_type(2)));
typedef unsigned u32x4 __attribute__((ext_vector_type(4)));
typedef unsigned u32x2 __attribute__((ext_vector_type(2)));

constexpr int D = 1024, SEQ = 16384, CTXL = 256, MT = SEQ + CTXL, DFF = 2816, NMODV = 9 * 1024, DEPTH = 4;
constexpr int NCH = MT / 64;
constexpr int GLA_NP = 3328;
constexpr float NORM_EPS = 1e-6f;
constexpr size_t MiB = 1u << 20;
constexpr size_t WS_MOD = 0, WS_ROPE = 1 * MiB, WS_WFI = 2 * MiB, WS_WFO = 90 * MiB, WS_WGI = 134 * MiB, WS_WGO = 147 * MiB, WS_WRI = 151 * MiB, WS_WRO = 157 * MiB,
                 WS_WRA = 160 * MiB, WS_WRX = 161 * MiB, WS_WSQ = 162 * MiB, WS_WSO = 165 * MiB, WS_X = 168 * MiB, WS_XN = 233 * MiB, WS_OB = 266 * MiB, WS_AR = 315 * MiB, WS_SLAB = 622 * MiB, WS_END = 634 * MiB;
constexpr size_t A_H = 0;
constexpr size_t A_P = 0, A_LR = 98 * MiB, A_QD = 101 * MiB, A_KN = 134 * MiB, A_DEC = 167 * MiB, A_US = 169 * MiB;
constexpr size_t A_GG = 0, A_XR = 49 * MiB, A_AP = 98 * MiB, A_HE = 102 * MiB, A_CIN = 106 * MiB, A_LA = 110 * MiB, A_UU = 208 * MiB;
constexpr size_t A_QKV = 0;
#ifndef DUP_MASK
#define DUP_MASK 0
#endif
constexpr int LDS_BYTES = 135168;
constexpr int LDS_MISC = 135168 - 64;
constexpr size_t WS_BAR = 640 * 1024, BAR_BYTES = 16384;
#ifndef PH_LIMIT
#define PH_LIMIT (1 << 20)
#endif

struct Args { const float* in[27]; float* out; unsigned char* ws; int ph_lo, ph_hi; };

struct Fr {
    LAS unsigned char* lds; int tid, lane, wave, G, bx;
    const float *x, *c, *ctx, *c_ctx, *ada_w, *ada_b, *norm_g, *final_g, *ffn_w_in, *ffn_w_out, *gla_w_in, *gla_w_a2, *gla_b_a, *gla_norm_g, *gla_w_out,
        *rg_w_in, *rg_conv_w, *rg_conv_b, *rg_w_a, *rg_b_a, *rg_w_x, *rg_b_x, *rg_lam, *rg_w_out, *swa_w_qkv, *swa_sink, *swa_w_out;
    float* out; unsigned char* ws;
    float *MOD, *ROPE, *X; bf16 *WFI, *WFO, *WGI, *WGO, *WRI, *WRO, *WRA, *WRX, *WSQ, *WSO, *XN, *OB, *H;
    bf16 *P, *QD, *KN, *US; float *LR, *DEC;
    bf16 *GG, *XR, *LAg, *UUg; float *AP, *HE, *CIN;
    bf16* QKV; float* SLAB;
};

typedef __bf16 bf16x2_t __attribute__((ext_vector_type(2)));
__device__ __forceinline__ unsigned pk2(float lo, float hi) { f32x2 v = {lo, hi}; bf16x2_t b = __builtin_convertvector(v, bf16x2_t); return __builtin_bit_cast(unsigned, b); }
__device__ __forceinline__ float bf2f(unsigned short b) { return __uint_as_float(((unsigned)b) << 16); }
__device__ __forceinline__ float bflo(unsigned u) { return __uint_as_float(u << 16); }
__device__ __forceinline__ float bfhi(unsigned u) { return __uint_as_float(u & 0xffff0000u); }
__device__ __forceinline__ unsigned short f2bf1(float f) { return (unsigned short)(pk2(f, 0.f) & 0xffffu); }
__device__ __forceinline__ float shx(float v, int o, int lane) { return __builtin_bit_cast(float, __builtin_amdgcn_ds_bpermute((lane ^ o) << 2, __builtin_bit_cast(int, v))); }
__device__ __forceinline__ float wave_sum(float v, int lane) {
#pragma unroll
    for (int o = 1; o < 64; o <<= 1) v += shx(v, o, lane);
    return v;
}
__device__ __forceinline__ f32x4 mma(bf16x8 a, bf16x8 b, f32x4 c) { return __builtin_amdgcn_mfma_f32_16x16x32_bf16(a, b, c, 0, 0, 0); }
__device__ __forceinline__ float sigmoidf_(float x) { return __builtin_amdgcn_rcpf(1.0f + __expf(-x)); }
__device__ __forceinline__ float siluf_(float x) { return x * sigmoidf_(x); }
__device__ __forceinline__ float gelu_tanh_(float x) { const float y = 0.7978845608028654f * (x + 0.044715f * x * x * x); return x * sigmoidf_(2.0f * y); }
__device__ __forceinline__ float logsigmoid_(float x) { return fminf(x, 0.f) - __logf(1.0f + __expf(-fabsf(x))); }
__device__ __forceinline__ float softplus_(float x) { return fmaxf(x, 0.f) + __logf(1.0f + __expf(-fabsf(x))); }
#define LDS_WAIT() asm volatile("s_waitcnt lgkmcnt(0)" ::: "memory")

using pg8::Unit;
struct EpiSwiglu {
    static constexpr bool PERM = true, AFTER_DRAIN = false;
    bf16* H;
    __device__ __forceinline__ void operator()(const f32x4 (&acc)[2][2][4][2], const Unit& u, int wr, int wc, int fr, int fq) const {
        int z0 = 0; asm volatile("" : "+v"(z0));
        const int row0 = u.pm * 256 + wr * 64 + fr + z0, col0 = u.pn * 128 + wc * 32 + 8 * fq;
#pragma unroll
        for (int ai = 0; ai < 2; ++ai)
#pragma unroll
            for (int m = 0; m < 4; ++m) {
                bf16* rowp = H + (size_t)(row0 + ai * 128 + m * 16) * DFF + col0;
                const f32x4 g0 = acc[ai][0][m][0], g1 = acc[ai][0][m][1], u0 = acc[ai][1][m][0], u1 = acc[ai][1][m][1];
                u32x4 w;
                w.x = pk2(siluf_(g0[0]) * u0[0], siluf_(g0[1]) * u0[1]); w.y = pk2(siluf_(g0[2]) * u0[2], siluf_(g0[3]) * u0[3]);
                w.z = pk2(siluf_(g1[0]) * u1[0], siluf_(g1[1]) * u1[1]); w.w = pk2(siluf_(g1[2]) * u1[2], siluf_(g1[3]) * u1[3]);
                *(u32x4*)rowp = w;
            }
    }
};
struct EpiResid {
    static constexpr bool PERM = false, AFTER_DRAIN = false;
    float* X; const float* modl; int gidx; float coef;
    __device__ __forceinline__ void operator()(const f32x4 (&acc)[2][2][4][2], const Unit& u, int wr, int wc, int fr, int fq) const {
        const float* gp = modl + (u.pm == 64 ? NMODV : 0) + gidx * 1024;
        int z0 = 0; asm volatile("" : "+v"(z0));
        const int row0 = u.pm * 256 + wr * 64 + fr + z0, col0 = u.pn * 256 + wc * 32 + 4 * fq;
#pragma unroll
        for (int bj = 0; bj < 2; ++bj)
#pragma unroll
            for (int n = 0; n < 2; ++n) {
                const int col = col0 + bj * 128 + n * 16;
                const f32x4 gv = *(const f32x4*)(gp + col) * coef;
#pragma unroll
                for (int ai = 0; ai < 2; ++ai)
#pragma unroll
                    for (int m = 0; m < 4; ++m) {
                        float* p = X + (size_t)(row0 + ai * 128 + m * 16) * D + col;
                        f32x4 v = *(const f32x4*)p; v += gv * acc[ai][bj][m][n]; *(f32x4*)p = v;
                    }
            }
    }
};
struct EpiGlaIn {
    static constexpr bool PERM = true, AFTER_DRAIN = false;
    bf16* P; float* LR;
    __device__ __forceinline__ void operator()(const f32x4 (&acc)[2][2][4][2], const Unit& u, int wr, int wc, int fr, int fq) const {
        int z0 = 0; asm volatile("" : "+v"(z0));
        const int row0 = u.pm * 256 + wr * 64 + fr + z0;
        if (u.pn < 12) {
            const float sc = (u.pn < 2) ? 0.08838834764831845f : 1.0f;
            const int col0 = u.pn * 256 + wc * 32 + 8 * fq;
#pragma unroll
            for (int ai = 0; ai < 2; ++ai)
#pragma unroll
                for (int m = 0; m < 4; ++m)
#pragma unroll
                    for (int bj = 0; bj < 2; ++bj) {
                        const f32x4 v0 = acc[ai][bj][m][0] * sc, v1 = acc[ai][bj][m][1] * sc;
                        u32x4 w; w.x = pk2(v0[0], v0[1]); w.y = pk2(v0[2], v0[3]); w.z = pk2(v1[0], v1[1]); w.w = pk2(v1[2], v1[3]);
                        *(u32x4*)(P + (size_t)(row0 + ai * 128 + m * 16) * 3072 + col0 + bj * 128) = w;
                    }
        } else if (wc == 0) {
#pragma unroll
            for (int ai = 0; ai < 2; ++ai)
#pragma unroll
                for (int m = 0; m < 4; ++m) {
                    float* p = LR + (size_t)(row0 + ai * 128 + m * 16) * 32 + 8 * fq;
                    *(f32x4*)p = acc[ai][0][m][0]; *(f32x4*)(p + 4) = acc[ai][0][m][1];
                }
        }
    }
};
struct EpiRgIn {
    static constexpr bool PERM = true, AFTER_DRAIN = false;
    bf16* GG; bf16* XR;
    __device__ __forceinline__ void operator()(const f32x4 (&acc)[2][2][4][2], const Unit& u, int wr, int wc, int fr, int fq) const {
        int z0 = 0; asm volatile("" : "+v"(z0));
        const int row0 = u.pm * 256 + wr * 64 + fr + z0;
        const bool isg = u.pn < 6;
        bf16* base = isg ? GG : XR;
        const int col0 = (isg ? u.pn : u.pn - 6) * 256 + wc * 32 + 8 * fq;
#pragma unroll
        for (int ai = 0; ai < 2; ++ai)
#pragma unroll
            for (int m = 0; m < 4; ++m)
#pragma unroll
                for (int bj = 0; bj < 2; ++bj) {
                    f32x4 v0 = acc[ai][bj][m][0], v1 = acc[ai][bj][m][1];
                    if (isg) {
#pragma unroll
                        for (int e = 0; e < 4; ++e) { v0[e] = gelu_tanh_(v0[e]); v1[e] = gelu_tanh_(v1[e]); }
                    }
                    u32x4 w; w.x = pk2(v0[0], v0[1]); w.y = pk2(v0[2], v0[3]); w.z = pk2(v1[0], v1[1]); w.w = pk2(v1[2], v1[3]);
                    *(u32x4*)(base + (size_t)(row0 + ai * 128 + m * 16) * 1536 + col0 + bj * 128) = w;
                }
    }
};
struct EpiSwaQkv {
    static constexpr bool PERM = false, AFTER_DRAIN = false;
    bf16* QKV; const float* rope;
    __device__ __forceinline__ void operator()(const f32x4 (&acc)[2][2][4][2], const Unit& u, int wr, int wc, int fr, int fq) const {
        int z0 = 0; asm volatile("" : "+v"(z0));
        const int row0 = u.pm * 256 + wr * 64 + fr + z0;
        const float sc = (u.pn < 4) ? 0.125f : 1.0f;
        const bool do_rope = (u.pn < 5) && (u.pm < 64);
        const int col0 = u.pn * 256 + wc * 32 + 4 * fq;
#pragma unroll
        for (int ai = 0; ai < 2; ++ai)
#pragma unroll
            for (int m = 0; m < 4; ++m) {
                const int row = row0 + ai * 128 + m * 16;
                f32x4 cs0 = {1.f, 0.f, 1.f, 0.f}, cs1 = {1.f, 0.f, 1.f, 0.f};
                if (do_rope) { const int id = (wc & 1) ? (row & 63) : (row >> 6); const float* tp = rope + (size_t)(id * 16 + 4 * fq) * 2; cs0 = *(const f32x4*)tp; cs1 = *(const f32x4*)(tp + 4); }
#pragma unroll
                for (int bj = 0; bj < 2; ++bj) {
                    const f32x4 x1 = acc[ai][bj][m][0] * sc, x2 = acc[ai][bj][m][1] * sc;
                    f32x4 o1, o2;
                    o1[0] = x1[0] * cs0[0] - x2[0] * cs0[1]; o2[0] = x2[0] * cs0[0] + x1[0] * cs0[1];
                    o1[1] = x1[1] * cs0[2] - x2[1] * cs0[3]; o2[1] = x2[1] * cs0[2] + x1[1] * cs0[3];
                    o1[2] = x1[2] * cs1[0] - x2[2] * cs1[1]; o2[2] = x2[2] * cs1[0] + x1[2] * cs1[1];
                    o1[3] = x1[3] * cs1[2] - x2[3] * cs1[3]; o2[3] = x2[3] * cs1[2] + x1[3] * cs1[3];
                    bf16* p = QKV + (size_t)row * 1536 + col0 + bj * 128;
                    u32x2 w1, w2; w1.x = pk2(o1[0], o1[1]); w1.y = pk2(o1[2], o1[3]); w2.x = pk2(o2[0], o2[1]); w2.y = pk2(o2[2], o2[3]);
                    *(u32x2*)p = w1; *(u32x2*)(p + 16) = w2;
                }
            }
    }
};

template <class Epi>
__device__ __forceinline__ void run_gemm(const Fr& F, const bf16* A, const bf16* Bt, int M, int N, int K, const Epi& E) {
    pg8::Gemm g{A, Bt, M, N, K, K}; pg8::StaticOrder S; S.init(M, N, F.G, F.bx);
    pg8::gemm_phase<Epi, pg8::StaticOrder, true, true>(F.lds, g, S, E, F.tid);
}


struct EpiSlab {
    static constexpr bool PERM = false, AFTER_DRAIN = false;
    float* SL; const float* modl; int gidx; float coef;
    __device__ __forceinline__ void operator()(const f32x4 (&acc)[2][2][4][2], const Unit& u, int wr, int wc, int fr, int fq) const {
        const float* gp = modl + NMODV + gidx * 1024;
        int z0 = 0; asm volatile("" : "+v"(z0));
        const int row0 = u.ks * 256 + wr * 64 + fr + z0, col0 = u.pn * 256 + wc * 32 + 4 * fq;
#pragma unroll
        for (int bj = 0; bj < 2; ++bj)
#pragma unroll
            for (int n = 0; n < 2; ++n) {
                const int col = col0 + bj * 128 + n * 16;
                const f32x4 gv = *(const f32x4*)(gp + col) * coef;
#pragma unroll
                for (int ai = 0; ai < 2; ++ai)
#pragma unroll
                    for (int m = 0; m < 4; ++m) *(f32x4*)(SL + (size_t)(row0 + ai * 128 + m * 16) * D + col) = gv * acc[ai][bj][m][n];
            }
    }
};
__device__ __forceinline__ void run_resid_gemm(const Fr& F, const bf16* A, const bf16* Bt, int K, bool with_ctx, const float* modl, int gidx, float coef) {
    { EpiResid E{F.X, modl, gidx, coef}; run_gemm(F, A, Bt, SEQ, D, K, E); }
    if (with_ctx) {
        pg8::Gemm g{A, Bt, MT, D, K, 256}; pg8::SplitKOrder S{64, 4, K / 256, F.G, F.bx};
        EpiSlab E{F.SLAB, modl, gidx, coef};
        int tid2 = F.tid; asm volatile("" : "+v"(tid2));
        pg8::gemm_phase<EpiSlab, pg8::SplitKOrder, false, false>(F.lds, g, S, E, tid2);
    }
}
__device__ __forceinline__ void xpose_item(const float* W, int K, int N, bf16* WT, int kb, int nb, int dst_row0, LAS float* scr, int lane) {
    const int k0 = 64 * kb, n0 = 32 * nb;
    float tv[32];
#pragma unroll
    for (int i = 0; i < 32; ++i) tv[i] = __builtin_nontemporal_load(&W[(size_t)(k0 + 2 * i + (lane >> 5)) * N + n0 + (lane & 31)]);
#pragma unroll
    for (int i = 0; i < 32; ++i) scr[(2 * i + (lane >> 5)) * 33 + (lane & 31)] = tv[i];
    LDS_WAIT(); asm volatile("" ::: "memory");
    const int c = lane & 7;
#pragma unroll
    for (int j = 0; j < 4; ++j) { const int n = (lane >> 3) + 8 * j; const LAS float* s = scr + (8 * c) * 33 + n;
        u32x4 o; o.x = pk2(s[0 * 33], s[1 * 33]); o.y = pk2(s[2 * 33], s[3 * 33]); o.z = pk2(s[4 * 33], s[5 * 33]); o.w = pk2(s[6 * 33], s[7 * 33]);
        *(u32x4*)(WT + (size_t)(dst_row0 + n) * K + k0 + 8 * c) = o; }
    LDS_WAIT(); asm volatile("" ::: "memory");
}

__device__ __forceinline__ void ph_prologue(const Fr& F) {
    LAS float* scr = (LAS float*)(F.lds + F.wave * 16384);
    const int gw = F.bx * 8 + F.wave, NGW = F.G * 8;
    constexpr int C1 = 22528, C2 = C1 + 11264, C3 = C2 + 3104, C4 = C3 + 1024, C5 = C4 + 1536, C6 = C5 + 768, C7 = C6 + 192, C8 = C7 + 192, C9 = C8 + 768, C10 = C9 + 512;
    for (int it = gw; it < C10; it += NGW) {
        if (it < C1) { const int mat = it / 2816, r = it % 2816, kb = r / 176, nb = r % 176, n0 = 32 * nb, half = n0 / DFF, jj = n0 % DFF;
            xpose_item(F.ffn_w_in + (size_t)mat * D * 2 * DFF, D, 2 * DFF, F.WFI + (size_t)mat * 2 * DFF * D, kb, nb, (jj / 128) * 256 + half * 128 + (jj % 128), scr, F.lane); }
        else if (it < C2) { const int q = it - C1, mat = q / 1408, r = q % 1408; xpose_item(F.ffn_w_out + (size_t)mat * DFF * D, DFF, D, F.WFO + (size_t)mat * D * DFF, r / 32, r % 32, 32 * (r % 32), scr, F.lane); }
        else if (it < C3) { const int q = it - C2, mat = q / 1552, r = q % 1552; xpose_item(F.gla_w_in + (size_t)mat * D * 3104, D, 3104, F.WGI + (size_t)mat * GLA_NP * D, r / 97, r % 97, 32 * (r % 97), scr, F.lane); }
        else if (it < C4) { const int q = it - C3, mat = q / 512, r = q % 512; xpose_item(F.gla_w_out + (size_t)mat * D * D, D, D, F.WGO + (size_t)mat * D * D, r / 32, r % 32, 32 * (r % 32), scr, F.lane); }
        else if (it < C5) { const int r = it - C4; xpose_item(F.rg_w_in, D, 3072, F.WRI, r / 96, r % 96, 32 * (r % 96), scr, F.lane); }
        else if (it < C6) { const int r = it - C5; xpose_item(F.rg_w_out, 1536, D, F.WRO, r / 32, r % 32, 32 * (r % 32), scr, F.lane); }
        else if (it < C7) { const int q = it - C6, mat = q / 8, r = q % 8; xpose_item(F.rg_w_a + (size_t)mat * 16384, 128, 128, F.WRA + (size_t)mat * 16384, r / 4, r % 4, 32 * (r % 4), scr, F.lane); }
        else if (it < C8) { const int q = it - C7, mat = q / 8, r = q % 8; xpose_item(F.rg_w_x + (size_t)mat * 16384, 128, 128, F.WRX + (size_t)mat * 16384, r / 4, r % 4, 32 * (r % 4), scr, F.lane); }
        else if (it < C9) { const int r = it - C8; xpose_item(F.swa_w_qkv, D, 1536, F.WSQ, r / 48, r % 48, 32 * (r % 48), scr, F.lane); }
        else { const int r = it - C9; xpose_item(F.swa_w_out, D, D, F.WSO, r / 32, r % 32, 32 * (r % 32), scr, F.lane); }
    }
    const int gt = F.bx * 512 + F.tid, NGT = F.G * 512;
    for (int i = gt; i < 2 * 224 * (D / 8); i += NGT) { const int mat = i / (224 * 128), r = i % (224 * 128); *(u32x4*)(F.WGI + (size_t)mat * GLA_NP * D + (size_t)3104 * D + (size_t)r * 8) = (u32x4){0u, 0u, 0u, 0u}; }
    for (int i = gt; i < MT * (D / 4); i += NGT) { const f32x4 v = (i < SEQ * (D / 4)) ? ((const f32x4*)F.x)[i] : ((const f32x4*)F.ctx)[i - SEQ * (D / 4)]; ((f32x4*)F.X)[i] = v; }
    if (gt == 0) *(unsigned*)(F.ws + 512 * 1024) = 0u;
    if (gt < 4096) { const int id = gt >> 4, f = gt & 15; const float freq = powf(10000.0f, -(float)(2 * f) / 32.0f); const float ang = (float)id * freq;
        const double rev = (double)ang * 0.15915494309189535; const float rr = (float)(rev - rint(rev));
        F.ROPE[2 * gt] = __builtin_amdgcn_cosf(rr); F.ROPE[2 * gt + 1] = __builtin_amdgcn_sinf(rr); }
    __syncthreads();
    LAS f32x4* red = (LAS f32x4*)F.lds;
    for (int b = F.bx; b < 4 * 72; b += F.G) {
        const int li = b / 72, c0 = (b % 72) * 128 + 2 * F.lane;
        const float* wp = F.ada_w + (size_t)li * D * NMODV + (size_t)(F.wave * 128) * NMODV + c0;
        float a0 = 0.f, a1 = 0.f, b0 = 0.f, b1 = 0.f;
#pragma unroll 32
        for (int k = 0; k < 128; ++k) { const f32x2 w = __builtin_nontemporal_load((const f32x2*)(wp + (size_t)k * NMODV)); const float sl = siluf_(F.c[F.wave * 128 + k]), sc = siluf_(F.c_ctx[F.wave * 128 + k]);
            a0 += sl * w.x; a1 += sl * w.y; b0 += sc * w.x; b1 += sc * w.y; }
        red[F.wave * 64 + F.lane] = (f32x4){a0, a1, b0, b1};
        __syncthreads();
        if (F.wave == 0) { f32x4 s = red[F.lane];
#pragma unroll
            for (int w = 1; w < 8; ++w) s += red[w * 64 + F.lane];
            const f32x2 bb = *(const f32x2*)(F.ada_b + (size_t)li * NMODV + c0);
            *(f32x2*)(F.MOD + (size_t)(li * 2 + 0) * NMODV + c0) = (f32x2){s[0] + bb.x, s[1] + bb.y};
            *(f32x2*)(F.MOD + (size_t)(li * 2 + 1) * NMODV + c0) = (f32x2){s[2] + bb.x, s[3] + bb.y}; }
        __syncthreads();
    }
}

__device__ __forceinline__ void ph_norm(const Fr& F, int layer, int k, int mrows, int nks) {
    const float* g = F.norm_g + (size_t)(layer * 3 + k) * D;
    const int gw = F.bx * 8 + F.wave, NGW = F.G * 8;
    f32x4 gs[4], sh[4];
    { const float* mod = F.MOD + (size_t)(layer * 2) * NMODV; const float* shift = mod + (3 * k) * 1024; const float* scale = mod + (3 * k + 1) * 1024;
#pragma unroll
      for (int j = 0; j < 4; ++j) { const int col = 4 * (F.lane + 64 * j); gs[j] = *(const f32x4*)(g + col) * (*(const f32x4*)(scale + col) + 1.0f); sh[j] = *(const f32x4*)(shift + col); } }
    int m = gw;
    f32x4 v[4];
    if (m < mrows) { const f32x4* xr = (const f32x4*)(F.X + (size_t)m * D) + F.lane;
#pragma unroll
        for (int j = 0; j < 4; ++j) v[j] = xr[64 * j]; }
    while (m < mrows) {
        const int mn = m + NGW;
        f32x4 vn[4];
        if (mn < mrows) { const f32x4* xr = (const f32x4*)(F.X + (size_t)mn * D) + F.lane;
#pragma unroll
            for (int j = 0; j < 4; ++j) vn[j] = xr[64 * j]; }
        f32x4 gsr[4], shr[4];
#pragma unroll
        for (int j = 0; j < 4; ++j) { gsr[j] = gs[j]; shr[j] = sh[j]; }
        if (m >= SEQ) {
            const float* mod = F.MOD + (size_t)(layer * 2 + 1) * NMODV; const float* shift = mod + (3 * k) * 1024; const float* scale = mod + (3 * k + 1) * 1024;
#pragma unroll
            for (int j = 0; j < 4; ++j) { const int col = 4 * (F.lane + 64 * j); gsr[j] = *(const f32x4*)(g + col) * (*(const f32x4*)(scale + col) + 1.0f); shr[j] = *(const f32x4*)(shift + col); }
            if (nks > 0) {
                for (int ks = 0; ks < nks; ks += 4) {
                    f32x4 t[4][4];
#pragma unroll
                    for (int i = 0; i < 4; ++i) { const f32x4* sp = (const f32x4*)(F.SLAB + ((size_t)(ks + i < nks ? ks + i : ks) * 256 + (m - SEQ)) * D) + F.lane;
#pragma unroll
                        for (int j = 0; j < 4; ++j) t[i][j] = sp[64 * j]; }
#pragma unroll
                    for (int i = 0; i < 4; ++i) if (ks + i < nks) {
#pragma unroll
                        for (int j = 0; j < 4; ++j) v[j] += t[i][j]; }
                }
                f32x4* xw = (f32x4*)(F.X + (size_t)m * D) + F.lane;
#pragma unroll
                for (int j = 0; j < 4; ++j) xw[64 * j] = v[j];
            }
        }
        float ss = 0.f;
#pragma unroll
        for (int j = 0; j < 4; ++j) ss += (v[j].x * v[j].x + v[j].y * v[j].y) + (v[j].z * v[j].z + v[j].w * v[j].w);
        const float rstd = __builtin_amdgcn_rsqf(wave_sum(ss, F.lane) * (1.0f / D) + NORM_EPS);
        u32x2* o8 = (u32x2*)(F.XN + (size_t)m * D) + F.lane;
#pragma unroll
        for (int j = 0; j < 4; ++j) { const f32x4 y = v[j] * rstd * gsr[j] + shr[j]; u32x2 w; w.x = pk2(y[0], y[1]); w.y = pk2(y[2], y[3]); o8[64 * j] = w; }
#pragma unroll
        for (int j = 0; j < 4; ++j) v[j] = vn[j];
        m = mn;
    }
}
__device__ __forceinline__ void ph_final(const Fr& F) {
    const int gw = F.bx * 8 + F.wave, NGW = F.G * 8;
    for (int m = gw; m < SEQ; m += NGW) {
        const f32x4* xr = (const f32x4*)(F.X + (size_t)m * D) + F.lane;
        f32x4 v[4]; float ss = 0.f;
#pragma unroll
        for (int j = 0; j < 4; ++j) { v[j] = xr[64 * j]; ss += (v[j].x * v[j].x + v[j].y * v[j].y) + (v[j].z * v[j].z + v[j].w * v[j].w); }
        const float rstd = __builtin_amdgcn_rsqf(wave_sum(ss, F.lane) * (1.0f / D) + NORM_EPS);
        f32x4* o = (f32x4*)(F.out + (size_t)m * D) + F.lane;
#pragma unroll
        for (int j = 0; j < 4; ++j) { const f32x4 gg = *(const f32x4*)(F.final_g + 4 * (F.lane + 64 * j)); o[64 * j] = v[j] * rstd * gg; }
    }
}

__device__ __forceinline__ void gla_b_unit(const Fr& F, int j, int n, int h, int z) {
    LAS unsigned char* lds = F.lds;
    LAS float* sLR = (LAS float*)(lds);
    LAS float* sW = (LAS float*)(lds + 4096);
    LAS float* sB = (LAS float*)(lds + 12288);
    LAS float* sSeg = (LAS float*)(lds + 45056);
    LAS bf16* sVT = (LAS bf16*)(lds + 47104);
    LAS bf16* sKT = (LAS bf16*)(lds + 83968);
    const int tid = F.tid, row0 = 64 * n;
    float lrv[2], wav[4];
#pragma unroll
    for (int i = 0; i < 2; ++i) { const int ii = tid + 512 * i, t = ii >> 4, r = ii & 15; lrv[i] = F.LR[(size_t)(row0 + t) * 32 + z * 16 + r]; }
#pragma unroll
    for (int i = 0; i < 4; ++i) { const int ii = tid + 512 * i, r = ii >> 7, k = ii & 127; wav[i] = F.gla_w_a2[((size_t)(j * 2 + z) * 16 + r) * 512 + h * 128 + k]; }
    const int tS = tid >> 3, d0S = (tid & 7) * 16, rowS = row0 + tS, e0S = (tid & 7) * 32;
    const bf16* qpS = F.P + (size_t)rowS * 3072 + h * 128 + d0S;
    const bf16x8 q0 = *(const bf16x8*)qpS, q1 = *(const bf16x8*)(qpS + 8), k0 = *(const bf16x8*)(qpS + 512), k1 = *(const bf16x8*)(qpS + 520);
    const bf16* vpS = F.P + (size_t)rowS * 3072 + 1024 + h * 256 + e0S;
    const bf16x8 vv0 = *(const bf16x8*)vpS, vv1 = *(const bf16x8*)(vpS + 8), vv2 = *(const bf16x8*)(vpS + 16), vv3 = *(const bf16x8*)(vpS + 24);
    const float bias = F.gla_b_a[(size_t)(j * 2 + z) * 512 + h * 128 + (tid & 127)];
#pragma unroll
    for (int i = 0; i < 2; ++i) sLR[tid + 512 * i] = lrv[i];
#pragma unroll
    for (int i = 0; i < 4; ++i) sW[tid + 512 * i] = wav[i];
#pragma unroll
    for (int i = 0; i < 8; ++i) { sVT[(e0S + i) * 72 + tS] = (unsigned short)vv0[i]; sVT[(e0S + 8 + i) * 72 + tS] = (unsigned short)vv1[i]; sVT[(e0S + 16 + i) * 72 + tS] = (unsigned short)vv2[i]; sVT[(e0S + 24 + i) * 72 + tS] = (unsigned short)vv3[i]; }
    __syncthreads();
    {
        const int k = tid & 127, tq = tid >> 7;
        float wv[16];
#pragma unroll
        for (int r = 0; r < 16; ++r) wv[r] = sW[r * 128 + k];
        float gv[16];
#pragma unroll
        for (int i = 0; i < 16; ++i) { const int t = tq * 16 + i; float a = bias;
            const f32x4 l0 = *(const LAS f32x4*)(sLR + t * 16), l1 = *(const LAS f32x4*)(sLR + t * 16 + 4), l2 = *(const LAS f32x4*)(sLR + t * 16 + 8), l3 = *(const LAS f32x4*)(sLR + t * 16 + 12);
#pragma unroll
            for (int r = 0; r < 4; ++r) { a += l0[r] * wv[r]; a += l1[r] * wv[4 + r]; a += l2[r] * wv[8 + r]; a += l3[r] * wv[12 + r]; }
            gv[i] = logsigmoid_(a) * (1.0f / 16.0f); }
        float run = 0.f;
        if (z == 0) {
#pragma unroll
            for (int i = 0; i < 16; ++i) { run += gv[i]; gv[i] = run; }
        } else {
#pragma unroll
            for (int i = 15; i >= 0; --i) { run += gv[i]; gv[i] = run; }
        }
        sSeg[tq * 128 + k] = run;
        __syncthreads();
        float off = 0.f;
#pragma unroll
        for (int q = 0; q < 4; ++q) { const float sv = sSeg[q * 128 + k]; if (z == 0 ? (q < tq) : (q > tq)) off += sv; }
#pragma unroll
        for (int i = 0; i < 16; ++i) sB[(tq * 16 + i) * 128 + k] = gv[i] + off;
    }
    __syncthreads();
    const int tl = (z == 0) ? 63 : 0;
    {
        const int t = tid >> 3, d0 = (tid & 7) * 16, row = row0 + t;
        float qd[16], kn[16];
#pragma unroll
        for (int i = 0; i < 16; ++i) {
            const float bt = sB[t * 128 + d0 + i], bl = sB[tl * 128 + d0 + i];
            const float qv = bf2f((unsigned short)(i < 8 ? q0[i] : q1[i - 8])), kv = bf2f((unsigned short)(i < 8 ? k0[i] : k1[i - 8]));
            qd[i] = qv * __expf(bt); kn[i] = kv * __expf(-bt);
            sKT[(d0 + i) * 72 + t] = f2bf1(kv * __expf(bl - bt));
        }
        u32x4 w0, w1;
        w0.x = pk2(qd[0], qd[1]); w0.y = pk2(qd[2], qd[3]); w0.z = pk2(qd[4], qd[5]); w0.w = pk2(qd[6], qd[7]);
        w1.x = pk2(qd[8], qd[9]); w1.y = pk2(qd[10], qd[11]); w1.z = pk2(qd[12], qd[13]); w1.w = pk2(qd[14], qd[15]);
        bf16* qo = F.QD + ((size_t)z * MT + row) * 512 + h * 128 + d0; *(u32x4*)qo = w0; *(u32x4*)(qo + 8) = w1;
        w0.x = pk2(kn[0], kn[1]); w0.y = pk2(kn[2], kn[3]); w0.z = pk2(kn[4], kn[5]); w0.w = pk2(kn[6], kn[7]);
        w1.x = pk2(kn[8], kn[9]); w1.y = pk2(kn[10], kn[11]); w1.z = pk2(kn[12], kn[13]); w1.w = pk2(kn[14], kn[15]);
        bf16* ko = F.KN + ((size_t)z * MT + row) * 512 + h * 128 + d0; *(u32x4*)ko = w0; *(u32x4*)(ko + 8) = w1;
        if (tid < 128) F.DEC[(size_t)(z * NCH + n) * 512 + h * 128 + tid] = __expf(sB[tl * 128 + tid]);
    }
    __syncthreads();
    {
        const int r = F.lane & 15, q = F.lane >> 4, w = F.wave;
        const bf16x8 a0 = *(const LAS bf16x8*)(sKT + (w * 16 + r) * 72 + q * 8), a1 = *(const LAS bf16x8*)(sKT + (w * 16 + r) * 72 + 32 + q * 8);
        bf16* USp = F.US + ((size_t)(z * NCH + n) * 4 + h) * 32768;
#pragma unroll 4
        for (int et = 0; et < 16; ++et) {
            const bf16x8 b0 = *(const LAS bf16x8*)(sVT + (et * 16 + r) * 72 + q * 8), b1 = *(const LAS bf16x8*)(sVT + (et * 16 + r) * 72 + 32 + q * 8);
            f32x4 acc = {0.f, 0.f, 0.f, 0.f}; acc = mma(a0, b0, acc); acc = mma(a1, b1, acc);
            u32x2 o; o.x = pk2(acc[0], acc[1]); o.y = pk2(acc[2], acc[3]);
            *(u32x2*)(USp + (size_t)((et * 8 + w) * 16 + r) * 16 + 4 * q) = o;
        }
    }
    __syncthreads();
}
__device__ __forceinline__ void gla_scan(const Fr& F) {
    for (int idx = F.bx * 512 + F.tid; idx < 131072; idx += F.G * 512) {
        const int o2 = 2 * (idx & 16383), h = (idx >> 14) & 3, z = idx >> 16, dd = ((o2 >> 8) & 7) * 16 + (o2 & 15);
        float s0 = 0.f, s1 = 0.f;
        constexpr int NB = 13;
        unsigned uA[NB], uB[NB]; f32x2 dA[NB], dB[NB]; unsigned *pA[NB], *pB[NB];
#define GS_LOAD(U, Dc, P, s_) { _Pragma("unroll") for (int i = 0; i < NB; ++i) { const int ss = (s_) + i, n = z ? (NCH - 1 - ss) : (ss < 4 ? 256 + ss : ss - 4); \
            P[i] = (unsigned*)(F.US + ((size_t)(z * NCH + n) * 4 + h) * 32768 + o2); U[i] = *P[i]; \
            Dc[i] = *(const f32x2*)(F.DEC + (size_t)(z * NCH + n) * 512 + h * 128 + dd); } }
#define GS_PROC(U, Dc, P) { _Pragma("unroll") for (int i = 0; i < NB; ++i) { *P[i] = pk2(s0, s1); s0 = Dc[i].x * s0 + bflo(U[i]); s1 = Dc[i].y * s1 + bfhi(U[i]); } }
        GS_LOAD(uA, dA, pA, 0)
#pragma unroll 1
        for (int s = 0; s < NCH; s += 2 * NB) {
            GS_LOAD(uB, dB, pB, s + NB)
            GS_PROC(uA, dA, pA)
            if (s + 2 * NB < NCH) GS_LOAD(uA, dA, pA, s + 2 * NB)
            GS_PROC(uB, dB, pB)
        }
#undef GS_LOAD
#undef GS_PROC
    }
}
__device__ __forceinline__ void gla_d_unit(const Fr& F, int j, int n, int h) {
    LAS unsigned char* lds = F.lds;
    LAS bf16* sVT = (LAS bf16*)(lds);
    LAS bf16* sAtt = (LAS bf16*)(lds + 36864);
    LAS float* sSS = (LAS float*)(lds + 55296);
    const int tid = F.tid, row0 = 64 * n, r = F.lane & 15, q = F.lane >> 4, w = F.wave;
    bf16x8 usf[2][4][2];
#pragma unroll
    for (int z = 0; z < 2; ++z) { const bf16* USz = F.US + ((size_t)(z * NCH + n) * 4 + h) * 32768;
#pragma unroll
        for (int ks = 0; ks < 4; ++ks) { const int dt = 2 * ks + (q >> 1), dl = 8 * (q & 1);
            usf[z][ks][0] = *(const bf16x8*)(USz + (size_t)(((2 * w) * 8 + dt) * 16 + r) * 16 + dl); usf[z][ks][1] = *(const bf16x8*)(USz + (size_t)(((2 * w + 1) * 8 + dt) * 16 + r) * 16 + dl); } }
    {
        const int t = tid >> 3, e0 = (tid & 7) * 32;
        const bf16* vp = F.P + (size_t)(row0 + t) * 3072 + 1024 + h * 256 + e0;
#pragma unroll
        for (int c = 0; c < 4; ++c) { const bf16x8 vv = *(const bf16x8*)(vp + 8 * c);
#pragma unroll
            for (int i = 0; i < 8; ++i) sVT[(e0 + 8 * c + i) * 72 + t] = (unsigned short)vv[i]; }
    }
    {
        const int z = w >> 2, tt = w & 3;
        const bf16* qdp = F.QD + ((size_t)z * MT + row0 + tt * 16 + r) * 512 + h * 128 + 8 * q;
        bf16x8 bq[4];
#pragma unroll
        for (int ks = 0; ks < 4; ++ks) bq[ks] = *(const bf16x8*)(qdp + 32 * ks);
        const int t = tt * 16 + r;
#pragma unroll
        for (int st = 0; st < 4; ++st) {
            const bf16* knp = F.KN + ((size_t)z * MT + row0 + st * 16 + r) * 512 + h * 128 + 8 * q;
            f32x4 acc = {0.f, 0.f, 0.f, 0.f};
#pragma unroll
            for (int ks = 0; ks < 4; ++ks) acc = mma(*(const bf16x8*)(knp + 32 * ks), bq[ks], acc);
#pragma unroll
            for (int jj = 0; jj < 4; ++jj) { const int s = st * 16 + 4 * q + jj; const bool keep = (z == 0) ? (s <= t) : (s >= t); if (!keep) acc[jj] = 0.f; }
            u32x2 o; o.x = pk2(acc[0], acc[1]); o.y = pk2(acc[2], acc[3]);
            *(LAS u32x2*)(sAtt + (z * 64 + t) * 72 + st * 16 + 4 * q) = o;
        }
    }
    __syncthreads();
    f32x4 acc[2][4];
#pragma unroll
    for (int ei = 0; ei < 2; ++ei)
#pragma unroll
        for (int tt = 0; tt < 4; ++tt) acc[ei][tt] = (f32x4){0.f, 0.f, 0.f, 0.f};
#pragma unroll
    for (int z = 0; z < 2; ++z) {
#pragma unroll
        for (int ks = 0; ks < 2; ++ks) {
            const bf16x8 a0 = *(const LAS bf16x8*)(sVT + (32 * w + r) * 72 + ks * 32 + 8 * q), a1 = *(const LAS bf16x8*)(sVT + (32 * w + 16 + r) * 72 + ks * 32 + 8 * q);
#pragma unroll
            for (int tt = 0; tt < 4; ++tt) { const bf16x8 b = *(const LAS bf16x8*)(sAtt + (z * 64 + tt * 16 + r) * 72 + ks * 32 + 8 * q);
                acc[0][tt] = mma(a0, b, acc[0][tt]); acc[1][tt] = mma(a1, b, acc[1][tt]); }
        }
        const bf16* QDz = F.QD + ((size_t)z * MT + row0 + r) * 512 + h * 128 + 8 * q;
#pragma unroll
        for (int ks = 0; ks < 4; ++ks) {
            const bf16x8 a0 = usf[z][ks][0], a1 = usf[z][ks][1];
#pragma unroll
            for (int tt = 0; tt < 4; ++tt) { const bf16x8 b = *(const bf16x8*)(QDz + (size_t)(tt * 16) * 512 + ks * 32);
                acc[0][tt] = mma(a0, b, acc[0][tt]); acc[1][tt] = mma(a1, b, acc[1][tt]); }
        }
    }
#pragma unroll
    for (int tt = 0; tt < 4; ++tt) {
        float ss = 0.f;
#pragma unroll
        for (int ei = 0; ei < 2; ++ei)
#pragma unroll
            for (int jj = 0; jj < 4; ++jj) ss += acc[ei][tt][jj] * acc[ei][tt][jj];
        ss += shx(ss, 16, F.lane); ss += shx(ss, 32, F.lane);
        if (q == 0) sSS[w * 64 + tt * 16 + r] = ss;
    }
    __syncthreads();
#pragma unroll
    for (int tt = 0; tt < 4; ++tt) {
        float tot = 0.f;
#pragma unroll
        for (int ww = 0; ww < 8; ++ww) tot += sSS[ww * 64 + tt * 16 + r];
        const float rstd = __builtin_amdgcn_rsqf(tot * (1.0f / 256.0f) + NORM_EPS);
        const size_t row = (size_t)(row0 + tt * 16 + r);
#pragma unroll
        for (int ei = 0; ei < 2; ++ei) {
            const int e = 32 * w + 16 * ei + 4 * q;
            const f32x4 g4 = *(const f32x4*)(F.gla_norm_g + (size_t)j * 256 + e);
            const u32x2 og = *(const u32x2*)(F.P + row * 3072 + 2048 + h * 256 + e);
            const float o0 = acc[ei][tt][0] * rstd * g4[0] * siluf_(bflo(og.x)), o1 = acc[ei][tt][1] * rstd * g4[1] * siluf_(bfhi(og.x));
            const float o2 = acc[ei][tt][2] * rstd * g4[2] * siluf_(bflo(og.y)), o3 = acc[ei][tt][3] * rstd * g4[3] * siluf_(bfhi(og.y));
            u32x2 o; o.x = pk2(o0, o1); o.y = pk2(o2, o3);
            *(u32x2*)(F.OB + row * 1024 + h * 256 + e) = o;
        }
    }
    __syncthreads();
}

__device__ __forceinline__ void rg_unit(const Fr& F, int n, int nb, int mode, int buf) {
    LAS unsigned char* lds = F.lds;
    LAS bf16* sXC = (LAS bf16*)(lds + buf * 17408);
    const int tid = F.tid, row0 = 64 * n, w = F.wave;
    LAS float* sA = (LAS float*)(lds + 34816 + w * 12288);
    LAS float* sU = sA + 1024;
    LAS float* sHS = sA + 2048;
    const int lo = (n >= 256) ? SEQ : 0, hi = (n >= 256) ? MT : SEQ;
    {
        const int cc = tid & 127, tq = tid >> 7, c = 128 * nb + cc;
        const float w0 = F.rg_conv_w[0 * 1536 + c], w1 = F.rg_conv_w[1 * 1536 + c], w2 = F.rg_conv_w[2 * 1536 + c], w3 = F.rg_conv_w[3 * 1536 + c], cb = F.rg_conv_b[c];
        const int tb = row0 + tq * 16;
        float xm2, xm1, x0, xp1;
        { const int r = tb - 2; xm2 = (r >= lo && r < hi) ? bf2f(F.XR[(size_t)r * 1536 + c]) : 0.f; }
        { const int r = tb - 1; xm1 = (r >= lo && r < hi) ? bf2f(F.XR[(size_t)r * 1536 + c]) : 0.f; }
        x0 = bf2f(F.XR[(size_t)tb * 1536 + c]);
#pragma unroll
        for (int i = 0; i < 16; ++i) {
            const int r = tb + i + 1; xp1 = (r < hi) ? bf2f(F.XR[(size_t)r * 1536 + c]) : 0.f;
            const float xc = cb + w0 * xm2 + w1 * xm1 + w2 * x0 + w3 * xp1;
            sXC[(tq * 16 + i) * 136 + cc] = f2bf1(xc);
            xm2 = xm1; xm1 = x0; x0 = xp1;
        }
    }
    __syncthreads();
    const int r = F.lane & 15, q = F.lane >> 4;
    const int c16 = 128 * nb + 16 * w;
#pragma unroll 1
    for (int z = 0; z < 2; ++z) {
        {
            const bf16* wa = F.WRA + ((size_t)(z * 12 + nb) * 128 + 16 * w + r) * 128 + 8 * q;
            const bf16* wx = F.WRX + ((size_t)(z * 12 + nb) * 128 + 16 * w + r) * 128 + 8 * q;
            f32x4 ra[4], ia[4];
#pragma unroll
            for (int tt = 0; tt < 4; ++tt) { ra[tt] = (f32x4){0.f, 0.f, 0.f, 0.f}; ia[tt] = (f32x4){0.f, 0.f, 0.f, 0.f}; }
#pragma unroll
            for (int ks = 0; ks < 4; ++ks) {
                const bf16x8 ar = *(const bf16x8*)(wa + 32 * ks), ai = *(const bf16x8*)(wx + 32 * ks);
#pragma unroll
                for (int tt = 0; tt < 4; ++tt) { const bf16x8 b = *(const LAS bf16x8*)(sXC + (tt * 16 + r) * 136 + ks * 32 + 8 * q); ra[tt] = mma(ar, b, ra[tt]); ia[tt] = mma(ai, b, ia[tt]); }
            }
            const int cl = 16 * w + 4 * q, c4 = 128 * nb + cl;
            const f32x4 ba = *(const f32x4*)(F.rg_b_a + z * 1536 + c4), bx = *(const f32x4*)(F.rg_b_x + z * 1536 + c4), lam = *(const f32x4*)(F.rg_lam + z * 1536 + c4);
            f32x4 coef;
#pragma unroll
            for (int jj = 0; jj < 4; ++jj) coef[jj] = -8.0f * softplus_(-lam[jj]);
#pragma unroll
            for (int tt = 0; tt < 4; ++tt) {
                const int t = tt * 16 + r;
                const u32x2 xw = *(const LAS u32x2*)(sXC + t * 136 + cl);
                const float xc[4] = {bflo(xw.x), bfhi(xw.x), bflo(xw.y), bfhi(xw.y)};
                f32x4 av, uv, lav;
#pragma unroll
                for (int jj = 0; jj < 4; ++jj) {
                    const float rr = sigmoidf_(ra[tt][jj] + ba[jj]), ii = sigmoidf_(ia[tt][jj] + bx[jj]);
                    const float la = coef[jj] * rr, x2 = 2.0f * la;
                    const float a = __expf(la);
                    const float ser = -x2 * (1.0f + x2 * (0.5f + x2 * (0.16666667f + x2 * (0.041666668f + x2 * 0.008333334f))));
                    const float om = (x2 > -0.25f) ? ser : (1.0f - a * a);
                    av[jj] = a; uv[jj] = __builtin_amdgcn_sqrtf(om) * (ii * xc[jj]); lav[jj] = la;
                }
                *(LAS f32x4*)(sA + t * 16 + 4 * q) = av; *(LAS f32x4*)(sU + t * 16 + 4 * q) = uv;
                { const size_t go = ((size_t)z * MT + row0 + t) * 1536 + c4; u32x2 lw, uw; lw.x = pk2(lav[0], lav[1]); lw.y = pk2(lav[2], lav[3]); uw.x = pk2(uv[0], uv[1]); uw.y = pk2(uv[2], uv[3]);
                  *(u32x2*)(F.LAg + go) = lw; *(u32x2*)(F.UUg + go) = uw; }
            }
        }
        asm volatile("s_waitcnt lgkmcnt(0)" ::: "memory");
        {
            const int cl = F.lane & 15, seg = F.lane >> 4, c = c16 + cl;
            float Pp = 1.f, Hh = 0.f;
            if (z == 0) {
#pragma unroll
                for (int i = 0; i < 16; ++i) { const int t = seg * 16 + i; const float a = sA[t * 16 + cl], u = sU[t * 16 + cl]; Hh = a * Hh + u; Pp *= a; } }
            else {
#pragma unroll
                for (int i = 15; i >= 0; --i) { const int t = seg * 16 + i; const float a = sA[t * 16 + cl], u = sU[t * 16 + cl]; Hh = a * Hh + u; Pp *= a; } }
            float sp[4], sh[4];
            sp[0] = Pp; sh[0] = Hh;
            sp[1] = shx(Pp, 16, F.lane); sh[1] = shx(Hh, 16, F.lane);
            sp[2] = shx(Pp, 32, F.lane); sh[2] = shx(Hh, 32, F.lane);
            sp[3] = shx(Pp, 48, F.lane); sh[3] = shx(Hh, 48, F.lane);
            if (mode == 0) {
                float Pt = 1.f, Ht = 0.f;
#pragma unroll
                for (int s2 = 0; s2 < 4; ++s2) { const int sg = (z == 0) ? s2 : 3 - s2;
                    float p_ = sp[0], h_ = sh[0];
#pragma unroll
                    for (int x = 1; x < 4; ++x) if ((seg ^ x) == sg) { p_ = sp[x]; h_ = sh[x]; }
                    Ht = p_ * Ht + h_; Pt *= p_; }
                if (seg == 0) { F.AP[(size_t)(z * NCH + n) * 1536 + c] = Pt; F.HE[(size_t)(z * NCH + n) * 1536 + c] = Ht; }
            } else {
                float hh = F.CIN[(size_t)(z * NCH + n) * 1536 + c];
#pragma unroll
                for (int s2 = 0; s2 < 4; ++s2) { const int sg = (z == 0) ? s2 : 3 - s2; const bool prior = (z == 0) ? (sg < seg) : (sg > seg);
                    float p_ = sp[0], h_ = sh[0];
#pragma unroll
                    for (int x = 1; x < 4; ++x) if ((seg ^ x) == sg) { p_ = sp[x]; h_ = sh[x]; }
                    if (prior) hh = p_ * hh + h_; }
                if (z == 0) {
#pragma unroll
                    for (int i = 0; i < 16; ++i) { const int t = seg * 16 + i; hh = sA[t * 16 + cl] * hh + sU[t * 16 + cl]; sHS[t * 16 + cl] = hh; } }
                else {
#pragma unroll
                    for (int i = 15; i >= 0; --i) { const int t = seg * 16 + i; hh = sA[t * 16 + cl] * hh + sU[t * 16 + cl]; sHS[t * 16 + cl] += hh; } }
            }
        }
        asm volatile("s_waitcnt lgkmcnt(0)" ::: "memory");
    }
    if (mode == 1) {
        const int t = F.lane; const size_t row = (size_t)(row0 + t);
        const u32x4 g0 = *(const u32x4*)(F.GG + row * 1536 + c16), g1 = *(const u32x4*)(F.GG + row * 1536 + c16 + 8);
        const f32x4 h0 = *(const LAS f32x4*)(sHS + t * 16), h1 = *(const LAS f32x4*)(sHS + t * 16 + 4), h2 = *(const LAS f32x4*)(sHS + t * 16 + 8), h3 = *(const LAS f32x4*)(sHS + t * 16 + 12);
        u32x4 o0, o1;
        o0.x = pk2(h0[0] * bflo(g0.x), h0[1] * bfhi(g0.x)); o0.y = pk2(h0[2] * bflo(g0.y), h0[3] * bfhi(g0.y)); o0.z = pk2(h1[0] * bflo(g0.z), h1[1] * bfhi(g0.z)); o0.w = pk2(h1[2] * bflo(g0.w), h1[3] * bfhi(g0.w));
        o1.x = pk2(h2[0] * bflo(g1.x), h2[1] * bfhi(g1.x)); o1.y = pk2(h2[2] * bflo(g1.y), h2[3] * bfhi(g1.y)); o1.z = pk2(h3[0] * bflo(g1.z), h3[1] * bfhi(g1.z)); o1.w = pk2(h3[2] * bflo(g1.w), h3[3] * bfhi(g1.w));
        *(u32x4*)(F.OB + row * 1536 + c16) = o0; *(u32x4*)(F.OB + row * 1536 + c16 + 8) = o1;
        asm volatile("s_waitcnt lgkmcnt(0)" ::: "memory");
    }
}
template <int CTRL, int RMASK> __device__ __forceinline__ float dppf(float oldv, float src) {
    return __builtin_bit_cast(float, __builtin_amdgcn_update_dpp(__builtin_bit_cast(int, oldv), __builtin_bit_cast(int, src), CTRL, RMASK, 0xf, false)); }
template <int CTRL, int RMASK> __device__ __forceinline__ void scan_step(float& P, float& H) {
    const float Pp = dppf<CTRL, RMASK>(1.0f, P), Hp = dppf<CTRL, RMASK>(0.0f, H);
    H = P * Hp + H; P = P * Pp; }
__device__ __forceinline__ void rg_unit1(const Fr& F, int n, int nb) {
    const int row0 = 64 * n, c16 = 128 * nb + 16 * F.wave, lane = F.lane;
    float hs[16];
#pragma unroll
    for (int z = 0; z < 2; ++z) {
        const int t = z ? 63 - lane : lane;
        const size_t go = ((size_t)z * MT + row0 + t) * 1536 + c16;
        const u32x4 l0 = *(const u32x4*)(F.LAg + go), l1 = *(const u32x4*)(F.LAg + go + 8), u0 = *(const u32x4*)(F.UUg + go), u1 = *(const u32x4*)(F.UUg + go + 8);
        const float* cp = F.CIN + (size_t)(z * NCH + n) * 1536 + c16;
        const f32x4 ci0 = *(const f32x4*)cp, ci1 = *(const f32x4*)(cp + 4), ci2 = *(const f32x4*)(cp + 8), ci3 = *(const f32x4*)(cp + 12);
        float P[16], H[16], ci[16];
#pragma unroll
        for (int k = 0; k < 4; ++k) { P[2 * k] = __expf(bflo(l0[k])); P[2 * k + 1] = __expf(bfhi(l0[k])); P[8 + 2 * k] = __expf(bflo(l1[k])); P[8 + 2 * k + 1] = __expf(bfhi(l1[k]));
            H[2 * k] = bflo(u0[k]); H[2 * k + 1] = bfhi(u0[k]); H[8 + 2 * k] = bflo(u1[k]); H[8 + 2 * k + 1] = bfhi(u1[k]);
            ci[k] = ci0[k]; ci[4 + k] = ci1[k]; ci[8 + k] = ci2[k]; ci[12 + k] = ci3[k]; }
#pragma unroll
        for (int ch = 0; ch < 16; ++ch) {
            float p = P[ch], h = H[ch];
            scan_step<0x111, 0xf>(p, h); scan_step<0x112, 0xf>(p, h); scan_step<0x114, 0xf>(p, h); scan_step<0x118, 0xf>(p, h);
            scan_step<0x142, 0xa>(p, h); scan_step<0x143, 0xc>(p, h);
            const float hv = p * ci[ch] + h;
            if (z == 0) hs[ch] = hv;
            else hs[ch] += __builtin_bit_cast(float, __builtin_amdgcn_ds_bpermute((63 - lane) << 2, __builtin_bit_cast(int, hv)));
        }
    }
    const size_t ro = (size_t)(row0 + lane) * 1536 + c16;
    const u32x4 g0 = *(const u32x4*)(F.GG + ro), g1 = *(const u32x4*)(F.GG + ro + 8);
    u32x4 o0, o1;
    o0.x = pk2(hs[0] * bflo(g0.x), hs[1] * bfhi(g0.x)); o0.y = pk2(hs[2] * bflo(g0.y), hs[3] * bfhi(g0.y)); o0.z = pk2(hs[4] * bflo(g0.z), hs[5] * bfhi(g0.z)); o0.w = pk2(hs[6] * bflo(g0.w), hs[7] * bfhi(g0.w));
    o1.x = pk2(hs[8] * bflo(g1.x), hs[9] * bfhi(g1.x)); o1.y = pk2(hs[10] * bflo(g1.y), hs[11] * bfhi(g1.y)); o1.z = pk2(hs[12] * bflo(g1.z), hs[13] * bfhi(g1.z)); o1.w = pk2(hs[14] * bflo(g1.w), hs[15] * bfhi(g1.w));
    *(u32x4*)(F.OB + ro) = o0; *(u32x4*)(F.OB + ro + 8) = o1;
}
__device__ __forceinline__ void rg_carry(const Fr& F) {
    const int lane = F.lane;
    for (int sq = F.bx * 8 + F.wave; sq < 3072; sq += F.G * 8) {
        const int z = sq / 1536, c = sq % 1536;
        float ap[5], he[5]; size_t off[5];
        float Pl = 1.f, Hl = 0.f;
#pragma unroll
        for (int i = 0; i < 5; ++i) { const int ss = 5 * lane + i; const bool ok = ss < NCH; const int sc = ok ? ss : 0, n = z ? (NCH - 1 - sc) : (sc < 4 ? 256 + sc : sc - 4);
            off[i] = (size_t)(z * NCH + n) * 1536 + c; ap[i] = ok ? F.AP[off[i]] : 1.f; he[i] = ok ? F.HE[off[i]] : 0.f; }
#pragma unroll
        for (int i = 0; i < 5; ++i) { Hl = ap[i] * Hl + he[i]; Pl *= ap[i]; }
        float Pi = Pl, Hi = Hl;
#pragma unroll
        for (int o = 1; o < 64; o <<= 1) {
            const int src = lane - o;
            const float Pp = __builtin_bit_cast(float, __builtin_amdgcn_ds_bpermute((src < 0 ? lane : src) << 2, __builtin_bit_cast(int, Pi)));
            const float Hp = __builtin_bit_cast(float, __builtin_amdgcn_ds_bpermute((src < 0 ? lane : src) << 2, __builtin_bit_cast(int, Hi)));
            if (src >= 0) { Hi = Pi * Hp + Hi; Pi = Pi * Pp; }
        }
        float hh = __builtin_bit_cast(float, __builtin_amdgcn_ds_bpermute((lane > 0 ? lane - 1 : 0) << 2, __builtin_bit_cast(int, Hi)));
        if (lane == 0) hh = 0.f;
#pragma unroll
        for (int i = 0; i < 5; ++i) { if (5 * lane + i < NCH) F.CIN[off[i]] = hh; hh = ap[i] * hh + he[i]; }
    }
}

__device__ __forceinline__ void swa_unit(const Fr& F, int qb, int kvh) {
    LAS unsigned char* lds = F.lds;
    LAS bf16* sK = (LAS bf16*)(lds);
    LAS bf16* sVT = (LAS bf16*)(lds + 9216);
    const int tid = F.tid, row0 = 64 * qb, r = F.lane & 15, q = F.lane >> 4, w = F.wave;
    const bool is_ctx = qb >= 256;
    const int hq = kvh * 4 + (w >> 1), qoff = 32 * (w & 1);
    bf16x8 bq[2][2];
#pragma unroll
    for (int qt = 0; qt < 2; ++qt)
#pragma unroll
        for (int ks = 0; ks < 2; ++ks) bq[qt][ks] = *(const bf16x8*)(F.QKV + (size_t)(row0 + qoff + 16 * qt + r) * 1536 + hq * 64 + 32 * ks + 8 * q);
    float mrun[2], lrun[2];
    f32x4 o[4][2];
    { const float sk = F.swa_sink[hq]; mrun[0] = sk; mrun[1] = sk; lrun[0] = (q == 0) ? 1.f : 0.f; lrun[1] = lrun[0]; }
#pragma unroll
    for (int dt = 0; dt < 4; ++dt) { o[dt][0] = (f32x4){0.f, 0.f, 0.f, 0.f}; o[dt][1] = (f32x4){0.f, 0.f, 0.f, 0.f}; }
    const int ntiles = is_ctx ? 4 : 9;
#pragma unroll 1
    for (int ti = 0; ti < ntiles; ++ti) {
        int krow0; bool local;
        if (ti < 4) { krow0 = SEQ + 64 * ti; local = false; }
        else { krow0 = row0 - 128 + 64 * (ti - 4); local = true; if (krow0 < 0 || krow0 >= SEQ) continue; }
        __syncthreads();
        {
            const int key = tid >> 3, d0 = (tid & 7) * 8;
            const bf16* kp = F.QKV + (size_t)(krow0 + key) * 1536 + 1024 + kvh * 64 + d0;
            *(LAS bf16x8*)(sK + key * 72 + d0) = *(const bf16x8*)kp;
            const bf16x8 vv = *(const bf16x8*)(kp + 256);
#pragma unroll
            for (int i = 0; i < 8; ++i) sVT[(d0 + i) * 72 + key] = (unsigned short)vv[i];
        }
        __syncthreads();
        f32x4 st[4][2];
#pragma unroll
        for (int kt = 0; kt < 4; ++kt) {
            const bf16x8 a0 = *(const LAS bf16x8*)(sK + (16 * kt + r) * 72 + 8 * q), a1 = *(const LAS bf16x8*)(sK + (16 * kt + r) * 72 + 32 + 8 * q);
#pragma unroll
            for (int qt = 0; qt < 2; ++qt) { f32x4 a = {0.f, 0.f, 0.f, 0.f}; a = mma(a0, bq[qt][0], a); a = mma(a1, bq[qt][1], a); st[kt][qt] = a; }
        }
        if (local) {
#pragma unroll
            for (int kt = 0; kt < 4; ++kt)
#pragma unroll
                for (int qt = 0; qt < 2; ++qt)
#pragma unroll
                    for (int jj = 0; jj < 4; ++jj) { const int kpos = krow0 + 16 * kt + 4 * q + jj, qpos = row0 + qoff + 16 * qt + r; const int dd = kpos - qpos; if (dd > 128 || dd < -128) st[kt][qt][jj] = -1e30f; }
        }
#pragma unroll
        for (int qt = 0; qt < 2; ++qt) {
            float tm = -1e30f;
#pragma unroll
            for (int kt = 0; kt < 4; ++kt)
#pragma unroll
                for (int jj = 0; jj < 4; ++jj) tm = fmaxf(tm, st[kt][qt][jj]);
            tm = fmaxf(tm, shx(tm, 16, F.lane)); tm = fmaxf(tm, shx(tm, 32, F.lane));
            const float mn = fmaxf(mrun[qt], tm), alpha = __expf(mrun[qt] - mn);
            mrun[qt] = mn; float ls = lrun[qt] * alpha;
#pragma unroll
            for (int dt = 0; dt < 4; ++dt) o[dt][qt] *= alpha;
#pragma unroll
            for (int kt = 0; kt < 4; ++kt)
#pragma unroll
                for (int jj = 0; jj < 4; ++jj) { const float p = __expf(st[kt][qt][jj] - mn); ls += p; st[kt][qt][jj] = p; }
            lrun[qt] = ls;
        }
#pragma unroll
        for (int kp = 0; kp < 2; ++kp) {
            bf16x8 bp[2];
#pragma unroll
            for (int qt = 0; qt < 2; ++qt) {
                u32x4 pw; pw.x = pk2(st[2 * kp][qt][0], st[2 * kp][qt][1]); pw.y = pk2(st[2 * kp][qt][2], st[2 * kp][qt][3]);
                pw.z = pk2(st[2 * kp + 1][qt][0], st[2 * kp + 1][qt][1]); pw.w = pk2(st[2 * kp + 1][qt][2], st[2 * kp + 1][qt][3]);
                bp[qt] = __builtin_bit_cast(bf16x8, pw);
            }
#pragma unroll
            for (int dt = 0; dt < 4; ++dt) {
                const u32x2 v0 = *(const LAS u32x2*)(sVT + (16 * dt + r) * 72 + 32 * kp + 4 * q), v1 = *(const LAS u32x2*)(sVT + (16 * dt + r) * 72 + 32 * kp + 16 + 4 * q);
                u32x4 vw; vw.x = v0.x; vw.y = v0.y; vw.z = v1.x; vw.w = v1.y;
                const bf16x8 av = __builtin_bit_cast(bf16x8, vw);
                o[dt][0] = mma(av, bp[0], o[dt][0]); o[dt][1] = mma(av, bp[1], o[dt][1]);
            }
        }
    }
#pragma unroll
    for (int qt = 0; qt < 2; ++qt) {
        float lt = lrun[qt]; lt += shx(lt, 16, F.lane); lt += shx(lt, 32, F.lane);
        const float inv = __builtin_amdgcn_rcpf(lt);
        bf16* op = F.OB + (size_t)(row0 + qoff + 16 * qt + r) * 1024 + hq * 64 + 4 * q;
#pragma unroll
        for (int dt = 0; dt < 4; ++dt) { const f32x4 v = o[dt][qt] * inv; u32x2 ow; ow.x = pk2(v[0], v[1]); ow.y = pk2(v[2], v[3]); *(u32x2*)(op + 16 * dt) = ow; }
    }
    __syncthreads();
}


#define CAS __attribute__((address_space(4)))
__device__ __forceinline__ const float* ld_in(const CAS unsigned char* kargp, int k) { asm volatile("" : "+s"(k)); return *(const float* const CAS*)(kargp + (size_t)k * 8); }
__device__ __forceinline__ unsigned char* ws_at(unsigned char* ws, unsigned long long off) { asm volatile("" : "+s"(off)); return ws + off; }
__device__ __forceinline__ void fill_ptrs(Fr& F, const CAS unsigned char* kargp) {
    F.x = ld_in(kargp, 0); F.c = ld_in(kargp, 1); F.ctx = ld_in(kargp, 2); F.c_ctx = ld_in(kargp, 3); F.ada_w = ld_in(kargp, 4); F.ada_b = ld_in(kargp, 5); F.norm_g = ld_in(kargp, 6); F.final_g = ld_in(kargp, 7);
    F.ffn_w_in = ld_in(kargp, 8); F.ffn_w_out = ld_in(kargp, 9); F.gla_w_in = ld_in(kargp, 10); F.gla_w_a2 = ld_in(kargp, 11); F.gla_b_a = ld_in(kargp, 12); F.gla_norm_g = ld_in(kargp, 13); F.gla_w_out = ld_in(kargp, 14);
    F.rg_w_in = ld_in(kargp, 15); F.rg_conv_w = ld_in(kargp, 16); F.rg_conv_b = ld_in(kargp, 17); F.rg_w_a = ld_in(kargp, 18); F.rg_b_a = ld_in(kargp, 19); F.rg_w_x = ld_in(kargp, 20); F.rg_b_x = ld_in(kargp, 21);
    F.rg_lam = ld_in(kargp, 22); F.rg_w_out = ld_in(kargp, 23); F.swa_w_qkv = ld_in(kargp, 24); F.swa_sink = ld_in(kargp, 25); F.swa_w_out = ld_in(kargp, 26);
    F.out = (float*)ld_in(kargp, 27); unsigned char* ws = (unsigned char*)ld_in(kargp, 28); F.ws = ws;
    F.MOD = (float*)ws_at(ws, WS_MOD); F.ROPE = (float*)ws_at(ws, WS_ROPE); F.X = (float*)ws_at(ws, WS_X);
    F.WFI = (bf16*)ws_at(ws, WS_WFI); F.WFO = (bf16*)ws_at(ws, WS_WFO); F.WGI = (bf16*)ws_at(ws, WS_WGI); F.WGO = (bf16*)ws_at(ws, WS_WGO); F.WRI = (bf16*)ws_at(ws, WS_WRI); F.WRO = (bf16*)ws_at(ws, WS_WRO);
    F.WRA = (bf16*)ws_at(ws, WS_WRA); F.WRX = (bf16*)ws_at(ws, WS_WRX); F.WSQ = (bf16*)ws_at(ws, WS_WSQ); F.WSO = (bf16*)ws_at(ws, WS_WSO);
    F.XN = (bf16*)ws_at(ws, WS_XN); F.OB = (bf16*)ws_at(ws, WS_OB); F.H = (bf16*)ws_at(ws, WS_AR + A_H);
    F.P = (bf16*)ws_at(ws, WS_AR + A_P); F.LR = (float*)ws_at(ws, WS_AR + A_LR); F.QD = (bf16*)ws_at(ws, WS_AR + A_QD); F.KN = (bf16*)ws_at(ws, WS_AR + A_KN); F.DEC = (float*)ws_at(ws, WS_AR + A_DEC); F.US = (bf16*)ws_at(ws, WS_AR + A_US);
    F.GG = (bf16*)ws_at(ws, WS_AR + A_GG); F.XR = (bf16*)ws_at(ws, WS_AR + A_XR); F.AP = (float*)ws_at(ws, WS_AR + A_AP); F.HE = (float*)ws_at(ws, WS_AR + A_HE); F.CIN = (float*)ws_at(ws, WS_AR + A_CIN); F.LAg = (bf16*)ws_at(ws, WS_AR + A_LA); F.UUg = (bf16*)ws_at(ws, WS_AR + A_UU);
    F.QKV = (bf16*)ws_at(ws, WS_AR + A_QKV); F.SLAB = (float*)ws_at(ws, WS_SLAB);
}

#ifdef DBG_CHECK
__device__ __forceinline__ bool bad16(unsigned short u) { return (u & 0x7f80u) == 0x7f80u; }
__device__ __forceinline__ bool bad32(unsigned u) { return (u & 0x7f800000u) == 0x7f800000u; }
__device__ __forceinline__ void dbg_scan(const Fr& F, unsigned* flag) {
    const size_t gt = (size_t)F.bx * 512 + F.tid, NGT = (size_t)F.G * 512;
    unsigned m = 0;
    for (size_t i = gt; i < (size_t)MT * 32; i += NGT) if (bad32(((const unsigned*)F.LR)[i])) m |= 1u;
    for (size_t i = gt; i < (size_t)MT * 3072; i += NGT) if (bad16(F.P[i])) m |= 2u;
    for (size_t i = gt; i < (size_t)2 * MT * 512; i += NGT) { if (bad16(F.QD[i])) m |= 4u; if (bad16(F.KN[i])) m |= 8u; }
    for (size_t i = gt; i < (size_t)2 * NCH * 4 * 32768; i += NGT) if (bad16(F.US[i])) m |= 16u;
    for (size_t i = gt; i < (size_t)MT * 1024; i += NGT) if (bad16(F.OB[i])) m |= 32u;
    if (m) atomicOr(flag, m);
}
#endif

#define XB_TMO      128
#define XB_XCNT(j)  (256  + 64 * (j))
#define XB_XSUB(j)  (1280 + 64 * (j))
#define XB_XGEN(j)  (2304 + 64 * (j))
#define XB_TOP      3328
#define XB_TOPGEN   3392
#define XCD_BAR_WORDS 3456
#define XB_SPIN_CAP (1u << 18)

__device__ __forceinline__ unsigned xb_ld(unsigned* p)              { return __hip_atomic_load(p, __ATOMIC_RELAXED, __HIP_MEMORY_SCOPE_AGENT); }
__device__ __forceinline__ unsigned xb_add(unsigned* p, unsigned v) { return __hip_atomic_fetch_add(p, v, __ATOMIC_RELAXED, __HIP_MEMORY_SCOPE_AGENT); }
__device__ __forceinline__ unsigned xb_xcc_id() { return (unsigned)__builtin_amdgcn_s_getreg((3 << 11) | 20) & 0xFu; }
#define XB_SPIN(cond, bar) do { unsigned _sp = 0; while (cond) { __builtin_amdgcn_s_sleep(1); \
    if ((++_sp & 255u) == 0u) { if (xb_ld(&(bar)[XB_TMO])) break; if (_sp > XB_SPIN_CAP) { atomicAdd(&(bar)[XB_TMO], 1u); break; } } } } while (0)

struct XcdBarrier {
    unsigned* bar; unsigned x;
    volatile LAS unsigned* st;
};

__device__ __forceinline__ XcdBarrier xcd_barrier_post(unsigned* bar, volatile LAS unsigned* st) {
    XcdBarrier b; b.bar = bar; b.x = xb_xcc_id(); b.st = st;
    if (threadIdx.x == 0) (void)xb_add(&bar[XB_XCNT(b.x)], 1u);
    return b;
}
__device__ __forceinline__ void xcd_barrier_complete(unsigned* bar, unsigned x, unsigned& nloc, unsigned& nx) {
    const unsigned G = gridDim.x * gridDim.y * gridDim.z;
    unsigned sum, cnt, mine, sp = 0u;
    for (;;) {
        sum = 0u; cnt = 0u; mine = 0u;
#pragma unroll
        for (unsigned j = 0; j < 16; ++j) { const unsigned c = xb_ld(&bar[XB_XCNT(j)]); sum += c; cnt += (c > 0u) ? 1u : 0u; mine = (j == x) ? c : mine; }
        if (sum == G) break;
        __builtin_amdgcn_s_sleep(1);
        if ((++sp & 255u) == 0u) { if (xb_ld(&bar[XB_TMO])) break; if (sp > XB_SPIN_CAP) { atomicAdd(&bar[XB_TMO], 1u); break; } }
    }
    nloc = mine > 0u ? mine : 1u; nx = cnt > 0u ? cnt : 1u;
}

__device__ __forceinline__ void xcd_barrier(const XcdBarrier& b) {
    asm volatile("s_waitcnt vmcnt(0)" ::: "memory");
    __syncthreads();
    if (threadIdx.x == 0) {
        unsigned* bar = b.bar;
        __builtin_amdgcn_s_waitcnt(0);
        unsigned nloc = b.st[0], nx = b.st[1];
        if (nloc == 0u) { xcd_barrier_complete(bar, b.x, nloc, nx); b.st[0] = nloc; b.st[1] = nx; }
        const unsigned old = xb_add(&bar[XB_XSUB(b.x)], 1u);
        const unsigned gen = old / nloc;
        if (old + 1u == (gen + 1u) * nloc) {
            __builtin_amdgcn_fence(__ATOMIC_RELEASE, "agent");
            asm volatile("s_waitcnt vmcnt(0)" ::: "memory");
            const unsigned og = xb_add(&bar[XB_TOP], 1u);
            const unsigned tg = og / nx;
            if (og + 1u == (tg + 1u) * nx) xb_add(&bar[XB_TOPGEN], 1u);
            else XB_SPIN(xb_ld(&bar[XB_TOPGEN]) == tg, bar);
            __builtin_amdgcn_fence(__ATOMIC_ACQUIRE, "agent");
            xb_add(&bar[XB_XGEN(b.x)], 1u);
            asm volatile("s_waitcnt vmcnt(0)" ::: "memory");
        } else {
            XB_SPIN(xb_ld(&bar[XB_XGEN(b.x)]) == gen, bar);
            __builtin_amdgcn_fence(__ATOMIC_ACQUIRE, "agent");
            asm volatile("s_waitcnt vmcnt(0)" ::: "memory");
        }
    }
    __syncthreads();
}


__global__ void __launch_bounds__(512) fwd_megakernel(Args args) {
    extern __shared__ __attribute__((aligned(16))) unsigned char lds_raw[];
    cg::grid_group grid = cg::this_grid();
    Fr B0;
    B0.lds = (LAS unsigned char*)lds_raw; B0.tid = 0; B0.lane = 0; B0.wave = __builtin_amdgcn_readfirstlane(threadIdx.x >> 6); B0.G = gridDim.x; B0.bx = blockIdx.x;
    const CAS unsigned char* kargp = (const CAS unsigned char*)__builtin_amdgcn_kernarg_segment_ptr();
    if (threadIdx.x < 16) ((LAS unsigned*)(B0.lds + LDS_MISC))[threadIdx.x] = 0u;
    __syncthreads();
    const XcdBarrier bar = xcd_barrier_post((unsigned*)(args.ws + WS_BAR), (volatile LAS unsigned*)(B0.lds + LDS_MISC));
    const int lo = args.ph_lo, hi = args.ph_hi;
    if (hi < 0) grid.sync();
    int ph = 0;
#define PH_BEGIN_G(g) if (ph >= lo && ph < hi) for (int rep_ = 0; rep_ < (int)((DUP_MASK >> (g)) & 1) + 1; ++rep_) { Fr F = B0; { unsigned m1_ = ~0u; asm volatile("" : "+s"(m1_)); F.lane = (int)__builtin_amdgcn_mbcnt_hi(m1_, __builtin_amdgcn_mbcnt_lo(m1_, 0u)); } asm volatile("" : "+s"(F.G)); asm volatile("" : "+s"(F.bx)); asm volatile("" : "+s"(F.wave)); F.tid = F.wave * 64 + F.lane; fill_ptrs(F, kargp);
#define PH_END xcd_barrier(bar); } ++ph;

    PH_BEGIN_G(0)
#ifndef NO_PRO
 ph_prologue(F);
#endif
 PH_END

#pragma unroll 1
    for (int layer = 0; layer < DEPTH; ++layer) {
        const int mix = layer % 3, j = layer / 3; const bool last = (layer == DEPTH - 1);
        PH_BEGIN_G(1) ph_norm(F, layer, 0, MT, layer == 0 ? 0 : DFF / 256); PH_END
        PH_BEGIN_G(2) { EpiSwiglu E{F.H}; run_gemm(F, F.XN, F.WFI + (size_t)(layer * 2 + 0) * 2 * DFF * D, MT, 2 * DFF, D, E); } PH_END
        PH_BEGIN_G(3) run_resid_gemm(F, F.H, F.WFO + (size_t)(layer * 2 + 0) * D * DFF, DFF, true, F.MOD + (size_t)layer * 2 * NMODV, 2, rep_ == (int)((DUP_MASK >> 3) & 1) ? 0.5f : 0.0f); PH_END
        PH_BEGIN_G(1) ph_norm(F, layer, 1, MT, DFF / 256); PH_END
        const int Mact = last ? SEQ : MT;
        if (mix == 0) {
            PH_BEGIN_G(4) { EpiGlaIn E{F.P, F.LR}; run_gemm(F, F.XN, F.WGI + (size_t)j * GLA_NP * D, MT, GLA_NP, D, E); } PH_END
            PH_BEGIN_G(6)
#ifndef NO_GLAB
 for (int u = F.bx; u < NCH * 8; u += F.G) gla_b_unit(F, j, u >> 3, (u >> 1) & 3, u & 1);
#endif
 PH_END
            PH_BEGIN_G(31)
#ifndef NO_GLAC
 gla_scan(F);
#endif
 PH_END
            PH_BEGIN_G(7)
#ifndef NO_GLAD
 { const int nu = (last ? 256 : NCH) * 4; for (int u = F.bx; u < nu; u += F.G) gla_d_unit(F, j, u >> 2, u & 3); }
#endif
 PH_END
            PH_BEGIN_G(5) run_resid_gemm(F, F.OB, F.WGO + (size_t)j * D * D, D, !last, F.MOD + (size_t)layer * 2 * NMODV, 5, rep_ == (int)((DUP_MASK >> 5) & 1) ? 1.0f : 0.0f); PH_END
        } else if (mix == 1) {
            PH_BEGIN_G(4) { EpiRgIn E{F.GG, F.XR}; run_gemm(F, F.XN, F.WRI, MT, 3072, D, E); } PH_END
            PH_BEGIN_G(8)
#ifndef NO_RG
 { int it_ = 0; for (int u = F.bx; u < NCH * 12; u += F.G, ++it_) rg_unit(F, u / 12, u % 12, 0, it_ & 1); __syncthreads(); }
#endif
 PH_END
            PH_BEGIN_G(9) rg_carry(F); PH_END
            PH_BEGIN_G(11)
#ifndef NO_RG
 for (int u = F.bx; u < NCH * 12; u += F.G) rg_unit1(F, u / 12, u % 12);
#endif
 PH_END
            PH_BEGIN_G(5) run_resid_gemm(F, F.OB, F.WRO, 1536, !last, F.MOD + (size_t)layer * 2 * NMODV, 5, rep_ == (int)((DUP_MASK >> 5) & 1) ? 1.0f : 0.0f); PH_END
        } else {
            PH_BEGIN_G(4) { EpiSwaQkv E{F.QKV, F.ROPE}; run_gemm(F, F.XN, F.WSQ, MT, 1536, D, E); } PH_END
            PH_BEGIN_G(10)
#ifndef NO_SWA
 for (int u = F.bx; u < NCH * 4; u += F.G) swa_unit(F, u >> 2, u & 3);
#endif
 PH_END
            PH_BEGIN_G(5) run_resid_gemm(F, F.OB, F.WSO, D, !last, F.MOD + (size_t)layer * 2 * NMODV, 5, rep_ == (int)((DUP_MASK >> 5) & 1) ? 1.0f : 0.0f); PH_END
        }
        PH_BEGIN_G(1) ph_norm(F, layer, 2, Mact, mix == 1 ? 1536 / 256 : D / 256); PH_END
        PH_BEGIN_G(2) { EpiSwiglu E{F.H}; run_gemm(F, F.XN, F.WFI + (size_t)(layer * 2 + 1) * 2 * DFF * D, Mact, 2 * DFF, D, E); } PH_END
        PH_BEGIN_G(3) run_resid_gemm(F, F.H, F.WFO + (size_t)(layer * 2 + 1) * D * DFF, DFF, !last, F.MOD + (size_t)layer * 2 * NMODV, 8, rep_ == (int)((DUP_MASK >> 3) & 1) ? 0.5f : 0.0f); PH_END
    }
#ifdef DBG_CHECK
    { Fr F = B0; { unsigned m1_ = ~0u; asm volatile("" : "+s"(m1_)); F.lane = (int)__builtin_amdgcn_mbcnt_hi(m1_, __builtin_amdgcn_mbcnt_lo(m1_, 0u)); } asm volatile("" : "+s"(F.G)); asm volatile("" : "+s"(F.bx)); asm volatile("" : "+s"(F.wave)); F.tid = F.wave * 64 + F.lane; fill_ptrs(F, kargp);
      unsigned* flag = (unsigned*)(F.ws + 512 * 1024);
      dbg_scan(F, flag);
      for (size_t i = (size_t)F.bx * 512 + F.tid; i < (size_t)SEQ * D; i += (size_t)F.G * 512) F.out[i] = 0.f;
      xcd_barrier(bar);
      if (F.bx == 0 && F.tid == 0) F.out[0] = 1000.0f * (float)(__hip_atomic_load(flag, __ATOMIC_RELAXED, __HIP_MEMORY_SCOPE_AGENT) + 1u);
    }
#else
    { Fr F = B0; { unsigned m1_ = ~0u; asm volatile("" : "+s"(m1_)); F.lane = (int)__builtin_amdgcn_mbcnt_hi(m1_, __builtin_amdgcn_mbcnt_lo(m1_, 0u)); } asm volatile("" : "+s"(F.G)); asm volatile("" : "+s"(F.bx)); asm volatile("" : "+s"(F.wave)); F.tid = F.wave * 64 + F.lane; fill_ptrs(F, kargp); ph_final(F); }
#endif
}

extern "C" void kernel_launch(void* const* d_in, const int* in_sizes, int n_in, void* d_out, int out_size, void* d_ws, size_t ws_size, hipStream_t stream) {
    static int grid = 0;
    if (grid == 0) {
        if (n_in != 27 || out_size != SEQ * D || ws_size < WS_END) { fprintf(stderr, "kernel_launch: unexpected shapes (n_in %d out %d ws %zu)\n", n_in, out_size, ws_size); grid = -1; return; }
        int dev = 0, cus = 0, per_cu = 0;
        hipGetDevice(&dev);
        hipDeviceGetAttribute(&cus, hipDeviceAttributeMultiprocessorCount, dev);
        hipFuncSetAttribute((const void*)fwd_megakernel, hipFuncAttributeMaxDynamicSharedMemorySize, LDS_BYTES);
        hipOccupancyMaxActiveBlocksPerMultiprocessor(&per_cu, (const void*)fwd_megakernel, 512, LDS_BYTES);
        if (per_cu < 1) { fprintf(stderr, "kernel_launch: occupancy query says %d blocks per CU\n", per_cu); per_cu = 1; }
        (void)hipGetLastError();
        grid = cus * 1;
        fprintf(stderr, "kernel_launch: grid %d (cus %d, per_cu %d)\n", grid, cus, per_cu);
    }
    if (grid < 0) return;
    if (hipMemsetAsync((char*)d_ws + WS_BAR, 0, BAR_BYTES, stream) != hipSuccess) { fprintf(stderr, "kernel_launch: memset failed\n"); return; }
    Args a{};
    for (int i = 0; i < 27; ++i) a.in[i] = (const float*)d_in[i];
    a.out = (float*)d_out; a.ws = (unsigned char*)d_ws; a.ph_lo = 0; a.ph_hi = PH_LIMIT;
    void* kargs[] = {&a};
    hipError_t e = hipLaunchCooperativeKernel((const void*)fwd_megakernel, dim3(grid), dim3(512), kargs, LDS_BYTES, stream);
    if (e != hipSuccess) fprintf(stderr, "cooperative launch failed: %s (grid %d)\n", hipGetErrorString(e), grid);
}
```

```cpp
#include <hip/hip_runtime.h>
#include <hip/hip_cooperative_groups.h>
#include <cstdio>
#include <cstdint>
namespace cg = cooperative_groups;
namespace pg8 {
#define PG8_LAS __attribute__((address_space(3)))
typedef unsigned short bf16_t;
typedef short bf16x8 __attribute__((ext_vector_type(8)));
typedef float f32x4 __attribute__((ext_vector_type(4)));
typedef unsigned u32x4 __attribute__((ext_vector_type(4)));
constexpr int BM = 256, BK = 64, HALF = 128, HTB = HALF * BK * 2  , STAGE_BYTES = 8 * HTB, NXCD = 8, WGM = 8;

__host__ __device__ __forceinline__ int lds_byte(int r, int c) { const int st = (r >> 4) * 2 + (c >> 5), rr = r & 15, cc = c & 31, ob = rr * 64 + cc * 2; return st * 1024 + (ob ^ (((ob >> 9) & 1) << 5)); }
__host__ __device__ __forceinline__ void stage_rc(int b, int& R, int& C) { const int st = b / 1024, sb = b % 1024, swz = sb ^ (((sb >> 9) & 1) << 5); R = (st >> 1) * 16 + swz / 64; C = (st & 1) * 32 + (swz % 64) / 2; }
__host__ __device__ __forceinline__ int perm32(int rho) { const int n = rho >> 4, i = rho & 15; return 8 * (i >> 2) + 4 * n + (i & 3); }

struct Unit { int pm, pn, ks; };
struct Gemm { const bf16_t* A; const bf16_t* Bt; int M, N, K, KS; };

struct StaticOrder {
    int nM, nN, nwg, G, c;
    __host__ __device__ void init(int M, int N, int G_, int c_) { nM = M / BM; nN = N / BM; nwg = nM * nN; G = G_; c = c_; }
    __host__ __device__ bool next(int i, Unit& u) const {
        const long L = (long)i * G + c; if (L >= nwg) return false;
        int wgid = (int)L; { const int q = nwg / NXCD, r = nwg % NXCD, xcd = wgid % NXCD, off = wgid / NXCD; wgid = (xcd < r ? xcd * (q + 1) : r * (q + 1) + (xcd - r) * q) + off; }
        const int nig = WGM * nN, gid = wgid / nig, fm = gid * WGM, gsz = (nM - fm) < WGM ? (nM - fm) : WGM;
        u.pm = fm + ((wgid % nig) % gsz); u.pn = (wgid % nig) / gsz; u.ks = 0; return true;
    }
    __device__ __forceinline__ void a_ready(const Unit&) const {}
    __device__ __forceinline__ void done(const Unit&) const {}
};
struct SplitKOrder {
    int pm, nN, nks, G, c;
    __host__ __device__ bool next(int i, Unit& u) const { const int L = i * G + c; if (L >= nN * nks) return false; u.pm = pm; u.pn = L % nN; u.ks = L / nN; return true; }
    __device__ __forceinline__ void a_ready(const Unit&) const {}
    __device__ __forceinline__ void done(const Unit&) const {}
};
__device__ __forceinline__ unsigned cvt_pk_bf16(float lo, float hi) { unsigned r; asm volatile("v_cvt_pk_bf16_f32 %0, %1, %2" : "=v"(r) : "v"(lo), "v"(hi)); return r; }
template <class Epi, class Sched, bool ALIGN_EPI = false, bool SP2 = false>
__device__ __forceinline__ void gemm_phase(PG8_LAS unsigned char* lds, const Gemm g, const Sched& S, const Epi& E, const int tid_in) {
    const int tid = tid_in, wid = __builtin_amdgcn_readfirstlane(tid >> 6), lane = tid & 63, wr = wid >> 2, wc = wid & 3, fr = lane & 15, fq = lane >> 4;
    const int K = g.K, nt = g.KS / BK; const size_t ksb = (size_t)g.KS * 2;
    unsigned voffA[2], voffB[2];
#pragma unroll
    for (int i = 0; i < 2; ++i) { int R, C; stage_rc(tid * 16 + i * 8192, R, C); const int Rb = Epi::PERM ? ((R & ~31) + perm32(R & 31)) : R;
        voffA[i] = (unsigned)(R * K + C) * 2u; voffB[i] = (unsigned)(Rb * K + C) * 2u; }
    const size_t kstep = (size_t)(BK * 2);
    const size_t hstep = (size_t)HALF * K * 2;
    const size_t tstep = 2 * hstep;
    const unsigned ldsw = (unsigned)wid * 1024u;
    const int aoff = lds_byte(wr * 64 + fr, fq * 8), boff = lds_byte(wc * 32 + fr, fq * 8);
#define PG8_SA(b, h) (((b) * 2 + (h)) * HTB)
#define PG8_SB(b, h) ((4 + (b) * 2 + (h)) * HTB)
#define PG8_STAGE(bufoff, gbase, voff) do { _Pragma("unroll") for (int _i = 0; _i < 2; ++_i) \
        __builtin_amdgcn_global_load_lds((const unsigned*)((const char*)(gbase) + (voff)[_i]), (PG8_LAS unsigned*)(lds + (bufoff) + ldsw + _i * 8192), 16, 0, 0); } while (0)
#define PG8_LDA(dst, b, h) do { _Pragma("unroll") for (int m = 0; m < 4; ++m) _Pragma("unroll") for (int k = 0; k < 2; ++k) dst[m][k] = *(const PG8_LAS bf16x8*)(lds + PG8_SA(b, h) + aoff + m * 2048 + k * 1024); } while (0)
#define PG8_LDB(dst, b, h) do { _Pragma("unroll") for (int n = 0; n < 2; ++n) _Pragma("unroll") for (int k = 0; k < 2; ++k) dst[n][k] = *(const PG8_LAS bf16x8*)(lds + PG8_SB(b, h) + boff + n * 2048 + k * 1024); } while (0)
#define PG8_MMA(ai, bj, At, Bt) do { __builtin_amdgcn_s_setprio(1); _Pragma("unroll") for (int m = 0; m < 4; ++m) _Pragma("unroll") for (int n = 0; n < 2; ++n) _Pragma("unroll") for (int k = 0; k < 2; ++k) \
        acc[ai][bj][m][n] = __builtin_amdgcn_mfma_f32_16x16x32_bf16(Bt[n][k], At[m][k], acc[ai][bj][m][n], 0, 0, 0); __builtin_amdgcn_s_setprio(0); } while (0)
#define PG8_WAIT_V(n) asm volatile("s_waitcnt vmcnt(" #n ")" ::: "memory")
#define PG8_WAIT_L(n) asm volatile("s_waitcnt lgkmcnt(" #n ")" ::: "memory")
#define PG8_BAR __builtin_amdgcn_s_barrier()
#define PG8_SCHED __builtin_amdgcn_sched_barrier(0)
    Unit cur, nxt; int ui = 0;
    if (!S.next(0, cur)) return;
    f32x4 acc[2][2][4][2];
#pragma unroll
    for (int a = 0; a < 2; ++a)
#pragma unroll
        for (int b = 0; b < 2; ++b)
#pragma unroll
            for (int m = 0; m < 4; ++m)
#pragma unroll
                for (int n = 0; n < 2; ++n) acc[a][b][m][n] = (f32x4){0.f, 0.f, 0.f, 0.f};
    bf16x8 At[4][2], B0[2][2], B1[2][2];
    const char* cA = (const char*)g.A + (size_t)cur.pm * tstep + (size_t)cur.ks * ksb; const char* cB = (const char*)g.Bt + (size_t)cur.pn * tstep + (size_t)cur.ks * ksb;
    S.a_ready(cur);
    if constexpr (SP2) {
        PG8_STAGE(PG8_SB(0, 0), cB, voffB); PG8_STAGE(PG8_SB(0, 1), cB + hstep, voffB); PG8_STAGE(PG8_SA(0, 0), cA, voffA); PG8_STAGE(PG8_SA(0, 1), cA + hstep, voffA);
        if (wr == 1) PG8_BAR;
        PG8_WAIT_V(2); PG8_BAR;
        PG8_STAGE(PG8_SB(1, 0), cB + kstep, voffB); PG8_STAGE(PG8_SA(1, 0), cA + kstep, voffA); PG8_STAGE(PG8_SB(1, 1), cB + hstep + kstep, voffB);
        PG8_WAIT_V(6); PG8_BAR;
    } else {
        PG8_STAGE(PG8_SB(0, 0), cB, voffB); PG8_STAGE(PG8_SA(0, 0), cA, voffA); PG8_STAGE(PG8_SB(0, 1), cB + hstep, voffB); PG8_STAGE(PG8_SA(0, 1), cA + hstep, voffA);
        if (wr == 1) PG8_BAR;
        PG8_WAIT_V(4); PG8_BAR;
        PG8_STAGE(PG8_SB(1, 0), cB + kstep, voffB); PG8_STAGE(PG8_SA(1, 0), cA + kstep, voffA); PG8_STAGE(PG8_SB(1, 1), cB + hstep + kstep, voffB);
        PG8_WAIT_V(6); PG8_BAR;
    }
    for (;;) {
        const bool has_next = S.next(ui + 1, nxt);
        const char* nA = has_next ? (const char*)g.A + (size_t)nxt.pm * tstep + (size_t)nxt.ks * ksb : cA; const char* nB = has_next ? (const char*)g.Bt + (size_t)nxt.pn * tstep + (size_t)nxt.ks * ksb : cB;
        for (int t = 0; t < nt; t += 2) {
            const bool last = (t == nt - 2);
            const char* a1 = cA + (size_t)(t + 1) * kstep;
            const char* a2 = last ? nA : cA + (size_t)(t + 2) * kstep; const char* b2 = last ? nB : cB + (size_t)(t + 2) * kstep;
            const char* a3 = a2 + kstep; const char* b3 = b2 + kstep;
            if (last && has_next) S.a_ready(nxt);
            if constexpr (SP2) {
            PG8_LDB(B0, 0, 0); PG8_LDB(B1, 0, 1); PG8_SCHED; PG8_LDA(At, 0, 0); PG8_STAGE(PG8_SA(1, 1), a1 + hstep, voffA);
            PG8_WAIT_V(8); PG8_WAIT_L(0); PG8_BAR; PG8_MMA(0, 0, At, B0); PG8_MMA(0, 1, At, B1); PG8_BAR; PG8_SCHED;
            PG8_LDA(At, 0, 1); PG8_STAGE(PG8_SB(0, 0), b2, voffB); PG8_STAGE(PG8_SB(0, 1), b2 + hstep, voffB); PG8_STAGE(PG8_SA(0, 0), a2, voffA);
            PG8_WAIT_V(8); PG8_WAIT_L(0); PG8_BAR; PG8_MMA(1, 0, At, B0); PG8_MMA(1, 1, At, B1); PG8_BAR; PG8_SCHED;
            PG8_LDB(B0, 1, 0); PG8_LDB(B1, 1, 1); PG8_SCHED; PG8_LDA(At, 1, 0); PG8_STAGE(PG8_SA(0, 1), a2 + hstep, voffA);
            PG8_WAIT_V(8); PG8_WAIT_L(0); PG8_BAR; PG8_MMA(0, 0, At, B0); PG8_MMA(0, 1, At, B1); PG8_BAR; PG8_SCHED;
            PG8_LDA(At, 1, 1); PG8_STAGE(PG8_SB(1, 0), b3, voffB); PG8_STAGE(PG8_SB(1, 1), b3 + hstep, voffB); PG8_STAGE(PG8_SA(1, 0), a3, voffA);
            PG8_WAIT_V(8); PG8_WAIT_L(0); PG8_BAR; PG8_MMA(1, 0, At, B0); PG8_MMA(1, 1, At, B1); PG8_BAR; PG8_SCHED;
            } else {
            PG8_LDB(B0, 0, 0); PG8_SCHED; PG8_LDA(At, 0, 0); PG8_STAGE(PG8_SA(1, 1), a1 + hstep, voffA);
            PG8_WAIT_L(8); PG8_BAR; PG8_WAIT_L(0); PG8_MMA(0, 0, At, B0); PG8_BAR; PG8_SCHED;
            PG8_LDB(B1, 0, 1); PG8_STAGE(PG8_SB(0, 0), b2, voffB);
            PG8_BAR; PG8_WAIT_L(0); PG8_MMA(0, 1, At, B1); PG8_BAR;
            PG8_LDA(At, 0, 1); PG8_STAGE(PG8_SA(0, 0), a2, voffA);
            PG8_BAR; PG8_WAIT_L(0); PG8_MMA(1, 0, At, B0); PG8_BAR; PG8_SCHED;
            PG8_STAGE(PG8_SB(0, 1), b2 + hstep, voffB);
            PG8_WAIT_V(6); PG8_BAR; PG8_MMA(1, 1, At, B1); PG8_BAR;
            PG8_LDB(B0, 1, 0); PG8_SCHED; PG8_LDA(At, 1, 0); PG8_STAGE(PG8_SA(0, 1), a2 + hstep, voffA);
            PG8_WAIT_L(8); PG8_BAR; PG8_WAIT_L(0); PG8_MMA(0, 0, At, B0); PG8_BAR; PG8_SCHED;
            PG8_LDB(B1, 1, 1); PG8_STAGE(PG8_SB(1, 0), b3, voffB);
            PG8_BAR; PG8_WAIT_L(0); PG8_MMA(0, 1, At, B1); PG8_BAR;
            PG8_LDA(At, 1, 1); PG8_STAGE(PG8_SA(1, 0), a3, voffA);
            PG8_BAR; PG8_WAIT_L(0); PG8_MMA(1, 0, At, B0); PG8_BAR; PG8_SCHED;
            PG8_STAGE(PG8_SB(1, 1), b3 + hstep, voffB);
            PG8_WAIT_V(6); PG8_BAR; PG8_MMA(1, 1, At, B1); PG8_BAR;
            }
        }
        if constexpr (ALIGN_EPI) { if (wr == 0) PG8_BAR; }
        if constexpr (!Epi::AFTER_DRAIN) { E(acc, cur, wr, wc, fr, fq); S.done(cur); }
        if (!has_next) break;
#pragma unroll
        for (int a = 0; a < 2; ++a)
#pragma unroll
            for (int b = 0; b < 2; ++b)
#pragma unroll
                for (int m = 0; m < 4; ++m)
#pragma unroll
                    for (int n = 0; n < 2; ++n) acc[a][b][m][n] = (f32x4){0.f, 0.f, 0.f, 0.f};
        cur = nxt; cA = nA; cB = nB; ++ui;
        if constexpr (ALIGN_EPI) { if (wr == 1) PG8_BAR; }
    }
    PG8_WAIT_V(0);
    if constexpr (!ALIGN_EPI) { if (wr == 0) PG8_BAR; }
    PG8_BAR;
    if constexpr (Epi::AFTER_DRAIN) { E.fused(acc, cur, wr, wc, fr, fq, lds, wid, lane); S.done(cur); }
#undef PG8_SA
#undef PG8_SB
#undef PG8_STAGE
#undef PG8_LDA
#undef PG8_LDB
#undef PG8_MMA
#undef PG8_WAIT_V
#undef PG8_WAIT_L
#undef PG8_BAR
#undef PG8_SCHED
}
}

#define LAS __attribute__((address_space(3)))
typedef unsigned short bf16;
typedef short bf16x8 __attribute__((ext_vector_type(8)));
typedef short bf16x4 __attribute__((ext_vector_type(4)));
typedef float f32x4 __attribute__((ext_vector_type(4)));
typedef float f32x2 __attribute__((ext_vector_type(2)));
typedef unsigned u32x4 __attribute__((ext_vector_type(4)));
typedef unsigned u32x2 __attribute__((ext_vector_type(2)));

constexpr int D = 1024, SEQ = 16384, CTXL = 256, MT = SEQ + CTXL, DFF = 2816, NMODV = 9 * 1024, DEPTH = 4;
constexpr int NCH = MT / 64;
constexpr int GLA_NP = 3328;
constexpr float NORM_EPS = 1e-6f;
constexpr size_t MiB = 1u << 20;
constexpr size_t WS_MOD = 0, WS_ROPE = 1 * MiB, WS_WFI = 2 * MiB, WS_WFO = 90 * MiB, WS_WGI = 134 * MiB, WS_WGO = 147 * MiB, WS_WRI = 151 * MiB, WS_WRO = 157 * MiB,
                 WS_WRA = 160 * MiB, WS_WRX = 161 * MiB, WS_WSQ = 162 * MiB, WS_WSO = 165 * MiB, WS_X = 168 * MiB, WS_XN = 233 * MiB, WS_OB = 266 * MiB, WS_AR = 315 * MiB, WS_SLAB = 622 * MiB, WS_END = 634 * MiB;
constexpr size_t A_H = 0;
constexpr size_t A_P = 0, A_LR = 98 * MiB, A_QD = 101 * MiB, A_KN = 134 * MiB, A_DEC = 167 * MiB, A_US = 169 * MiB;
constexpr size_t A_GG = 0, A_XR = 49 * MiB, A_AP = 98 * MiB, A_HE = 102 * MiB, A_CIN = 106 * MiB, A_LA = 110 * MiB, A_UU = 208 * MiB;
constexpr size_t A_QKV = 0;
#ifndef DUP_MASK
#define DUP_MASK 0
#endif
constexpr int LDS_BYTES = 135168;
constexpr int LDS_MISC = 135168 - 64;
constexpr size_t WS_BAR = 640 * 1024, BAR_BYTES = 16384;
#ifndef PH_LIMIT
#define PH_LIMIT (1 << 20)
#endif

struct Args { const float* in[27]; float* out; unsigned char* ws; int ph_lo, ph_hi; };

struct Fr {
    LAS unsigned char* lds; int tid, lane, wave, G, bx;
    const float *x, *c, *ctx, *c_ctx, *ada_w, *ada_b, *norm_g, *final_g, *ffn_w_in, *ffn_w_out, *gla_w_in, *gla_w_a2, *gla_b_a, *gla_norm_g, *gla_w_out,
        *rg_w_in, *rg_conv_w, *rg_conv_b, *rg_w_a, *rg_b_a, *rg_w_x, *rg_b_x, *rg_lam, *rg_w_out, *swa_w_qkv, *swa_sink, *swa_w_out;
    float* out; unsigned char* ws;
    float *MOD, *ROPE, *X; bf16 *WFI, *WFO, *WGI, *WGO, *WRI, *WRO, *WRA, *WRX, *WSQ, *WSO, *XN, *OB, *H;
    bf16 *P, *QD, *KN, *US; float *LR, *DEC;
    bf16 *GG, *XR, *LAg, *UUg; float *AP, *HE, *CIN;
    bf16* QKV; float* SLAB;
};

typedef __bf16 bf16x2_t __attribute__((ext_vector_type(2)));
__device__ __forceinline__ unsigned pk2(float lo, float hi) { f32x2 v = {lo, hi}; bf16x2_t b = __builtin_convertvector(v, bf16x2_t); return __builtin_bit_cast(unsigned, b); }
__device__ __forceinline__ float bf2f(unsigned short b) { return __uint_as_float(((unsigned)b) << 16); }
__device__ __forceinline__ float bflo(unsigned u) { return __uint_as_float(u << 16); }
__device__ __forceinline__ float bfhi(unsigned u) { return __uint_as_float(u & 0xffff0000u); }
__device__ __forceinline__ unsigned short f2bf1(float f) { return (unsigned short)(pk2(f, 0.f) & 0xffffu); }
__device__ __forceinline__ float shx(float v, int o, int lane) { return __builtin_bit_cast(float, __builtin_amdgcn_ds_bpermute((lane ^ o) << 2, __builtin_bit_cast(int, v))); }
__device__ __forceinline__ float wave_sum(float v, int lane) {
#pragma unroll
    for (int o = 1; o < 64; o <<= 1) v += shx(v, o, lane);
    return v;
}
__device__ __forceinline__ f32x4 mma(bf16x8 a, bf16x8 b, f32x4 c) { return __builtin_amdgcn_mfma_f32_16x16x32_bf16(a, b, c, 0, 0, 0); }
__device__ __forceinline__ float sigmoidf_(float x) { return __builtin_amdgcn_rcpf(1.0f + __expf(-x)); }
__device__ __forceinline__ float siluf_(float x) { return x * sigmoidf_(x); }
__device__ __forceinline__ float gelu_tanh_(float x) { const float y = 0.7978845608028654f * (x + 0.044715f * x * x * x); return x * sigmoidf_(2.0f * y); }
__device__ __forceinline__ float logsigmoid_(float x) { return fminf(x, 0.f) - __logf(1.0f + __expf(-fabsf(x))); }
__device__ __forceinline__ float softplus_(float x) { return fmaxf(x, 0.f) + __logf(1.0f + __expf(-fabsf(x))); }
#define LDS_WAIT() asm volatile("s_waitcnt lgkmcnt(0)" ::: "memory")

using pg8::Unit;
struct EpiSwiglu {
    static constexpr bool PERM = true, AFTER_DRAIN = false;
    bf16* H;
    __device__ __forceinline__ void operator()(const f32x4 (&acc)[2][2][4][2], const Unit& u, int wr, int wc, int fr, int fq) const {
        int z0 = 0; asm volatile("" : "+v"(z0));
        const int row0 = u.pm * 256 + wr * 64 + fr + z0, col0 = u.pn * 128 + wc * 32 + 8 * fq;
#pragma unroll
        for (int ai = 0; ai < 2; ++ai)
#pragma unroll
            for (int m = 0; m < 4; ++m) {
                bf16* rowp = H + (size_t)(row0 + ai * 128 + m * 16) * DFF + col0;
                const f32x4 g0 = acc[ai][0][m][0], g1 = acc[ai][0][m][1], u0 = acc[ai][1][m][0], u1 = acc[ai][1][m][1];
                u32x4 w;
                w.x = pk2(siluf_(g0[0]) * u0[0], siluf_(g0[1]) * u0[1]); w.y = pk2(siluf_(g0[2]) * u0[2], siluf_(g0[3]) * u0[3]);
                w.z = pk2(siluf_(g1[0]) * u1[0], siluf_(g1[1]) * u1[1]); w.w = pk2(siluf_(g1[2]) * u1[2], siluf_(g1[3]) * u1[3]);
                *(u32x4*)rowp = w;
            }
    }
};
struct EpiResid {
    static constexpr bool PERM = false, AFTER_DRAIN = false;
    float* X; const float* modl; int gidx; float coef;
    __device__ __forceinline__ void operator()(const f32x4 (&acc)[2][2][4][2], const Unit& u, int wr, int wc, int fr, int fq) const {
        const float* gp = modl + (u.pm == 64 ? NMODV : 0) + gidx * 1024;
        int z0 = 0; asm volatile("" : "+v"(z0));
        const int row0 = u.pm * 256 + wr * 64 + fr + z0, col0 = u.pn * 256 + wc * 32 + 4 * fq;
#pragma unroll
        for (int bj = 0; bj < 2; ++bj)
#pragma unroll
            for (int n = 0; n < 2; ++n) {
                const int col = col0 + bj * 128 + n * 16;
                const f32x4 gv = *(const f32x4*)(gp + col) * coef;
#pragma unroll
                for (int ai = 0; ai < 2; ++ai)
#pragma unroll
                    for (int m = 0; m < 4; ++m) {
                        float* p = X + (size_t)(row0 + ai * 128 + m * 16) * D + col;
                        f32x4 v = *(const f32x4*)p; v += gv * acc[ai][bj][m][n]; *(f32x4*)p = v;
                    }
            }
    }
};
struct EpiGlaIn {
    static constexpr bool PERM = true, AFTER_DRAIN = false;
    bf16* P; float* LR;
    __device__ __forceinline__ void operator()(const f32x4 (&acc)[2][2][4][2], const Unit& u, int wr, int wc, int fr, int fq) const {
        int z0 = 0; asm volatile("" : "+v"(z0));
        const int row0 = u.pm * 256 + wr * 64 + fr + z0;
        if (u.pn < 12) {
            const float sc = (u.pn < 2) ? 0.08838834764831845f : 1.0f;
            const int col0 = u.pn * 256 + wc * 32 + 8 * fq;
#pragma unroll
            for (int ai = 0; ai < 2; ++ai)
#pragma unroll
                for (int m = 0; m < 4; ++m)
#pragma unroll
                    for (int bj = 0; bj < 2; ++bj) {
                        const f32x4 v0 = acc[ai][bj][m][0] * sc, v1 = acc[ai][bj][m][1] * sc;
                        u32x4 w; w.x = pk2(v0[0], v0[1]); w.y = pk2(v0[2], v0[3]); w.z = pk2(v1[0], v1[1]); w.w = pk2(v1[2], v1[3]);
                        *(u32x4*)(P + (size_t)(row0 + ai * 128 + m * 16) * 3072 + col0 + bj * 128) = w;
                    }
        } else if (wc == 0) {
#pragma unroll
            for (int ai = 0; ai < 2; ++ai)
#pragma unroll
                for (int m = 0; m < 4; ++m) {
                    float* p = LR + (size_t)(row0 + ai * 128 + m * 16) * 32 + 8 * fq;
                    *(f32x4*)p = acc[ai][0][m][0]; *(f32x4*)(p + 4) = acc[ai][0][m][1];
                }
        }
    }
};
struct EpiRgIn {
    static constexpr bool PERM = true, AFTER_DRAIN = false;
    bf16* GG; bf16* XR;
    __device__ __forceinline__ void operator()(const f32x4 (&acc)[2][2][4][2], const Unit& u, int wr, int wc, int fr, int fq) const {
        int z0 = 0; asm volatile("" : "+v"(z0));
        const int row0 = u.pm * 256 + wr * 64 + fr + z0;
        const bool isg = u.pn < 6;
        bf16* base = isg ? GG : XR;
        const int col0 = (isg ? u.pn : u.pn - 6) * 256 + wc * 32 + 8 * fq;
#pragma unroll
        for (int ai = 0; ai < 2; ++ai)
#pragma unroll
            for (int m = 0; m < 4; ++m)
#pragma unroll
                for (int bj = 0; bj < 2; ++bj) {
                    f32x4 v0 = acc[ai][bj][m][0], v1 = acc[ai][bj][m][1];
                    if (isg) {
#pragma unroll
                        for (int e = 0; e < 4; ++e) { v0[e] = gelu_tanh_(v0[e]); v1[e] = gelu_tanh_(v1[e]); }
                    }
                    u32x4 w; w.x = pk2(v0[0], v0[1]); w.y = pk2(v0[2], v0[3]); w.z = pk2(v1[0], v1[1]); w.w = pk2(v1[2], v1[3]);
                    *(u32x4*)(base + (size_t)(row0 + ai * 128 + m * 16) * 1536 + col0 + bj * 128) = w;
                }
    }
};
struct EpiSwaQkv {
    static constexpr bool PERM = false, AFTER_DRAIN = false;
    bf16* QKV; const float* rope;
    __device__ __forceinline__ void operator()(const f32x4 (&acc)[2][2][4][2], const Unit& u, int wr, int wc, int fr, int fq) const {
        int z0 = 0; asm volatile("" : "+v"(z0));
        const int row0 = u.pm * 256 + wr * 64 + fr + z0;
        const float sc = (u.pn < 4) ? 0.125f : 1.0f;
        const bool do_rope = (u.pn < 5) && (u.pm < 64);
        const int col0 = u.pn * 256 + wc * 32 + 4 * fq;
#pragma unroll
        for (int ai = 0; ai < 2; ++ai)
#pragma unroll
            for (int m = 0; m < 4; ++m) {
                const int row = row0 + ai * 128 + m * 16;
                f32x4 cs0 = {1.f, 0.f, 1.f, 0.f}, cs1 = {1.f, 0.f, 1.f, 0.f};
                if (do_rope) { const int id = (wc & 1) ? (row & 63) : (row >> 6); const float* tp = rope + (size_t)(id * 16 + 4 * fq) * 2; cs0 = *(const f32x4*)tp; cs1 = *(const f32x4*)(tp + 4); }
#pragma unroll
                for (int bj = 0; bj < 2; ++bj) {
                    const f32x4 x1 = acc[ai][bj][m][0] * sc, x2 = acc[ai][bj][m][1] * sc;
                    f32x4 o1, o2;
                    o1[0] = x1[0] * cs0[0] - x2[0] * cs0[1]; o2[0] = x2[0] * cs0[0] + x1[0] * cs0[1];
                    o1[1] = x1[1] * cs0[2] - x2[1] * cs0[3]; o2[1] = x2[1] * cs0[2] + x1[1] * cs0[3];
                    o1[2] = x1[2] * cs1[0] - x2[2] * cs1[1]; o2[2] = x2[2] * cs1[0] + x1[2] * cs1[1];
                    o1[3] = x1[3] * cs1[2] - x2[3] * cs1[3]; o2[3] = x2[3] * cs1[2] + x1[3] * cs1[3];
                    bf16* p = QKV + (size_t)row * 1536 + col0 + bj * 128;
                    u32x2 w1, w2; w1.x = pk2(o1[0], o1[1]); w1.y = pk2(o1[2], o1[3]); w2.x = pk2(o2[0], o2[1]); w2.y = pk2(o2[2], o2[3]);
                    *(u32x2*)p = w1; *(u32x2*)(p + 16) = w2;
                }
            }
    }
};

template <class Epi>
__device__ __forceinline__ void run_gemm(const Fr& F, const bf16* A, const bf16* Bt, int M, int N, int K, const Epi& E) {
    pg8::Gemm g{A, Bt, M, N, K, K}; pg8::StaticOrder S; S.init(M, N, F.G, F.bx);
    pg8::gemm_phase<Epi, pg8::StaticOrder, true, true>(F.lds, g, S, E, F.tid);
}


struct EpiSlab {
    static constexpr bool PERM = false, AFTER_DRAIN = false;
    float* SL; const float* modl; int gidx; float coef;
    __device__ __forceinline__ void operator()(const f32x4 (&acc)[2][2][4][2], const Unit& u, int wr, int wc, int fr, int fq) const {
        const float* gp = modl + NMODV + gidx * 1024;
        int z0 = 0; asm volatile("" : "+v"(z0));
        const int row0 = u.ks * 256 + wr * 64 + fr + z0, col0 = u.pn * 256 + wc * 32 + 4 * fq;
#pragma unroll
        for (int bj = 0; bj < 2; ++bj)
#pragma unroll
            for (int n = 0; n < 2; ++n) {
                const int col = col0 + bj * 128 + n * 16;
                const f32x4 gv = *(const f32x4*)(gp + col) * coef;
#pragma unroll
                for (int ai = 0; ai < 2; ++ai)
#pragma unroll
                    for (int m = 0; m < 4; ++m) *(f32x4*)(SL + (size_t)(row0 + ai * 128 + m * 16) * D + col) = gv * acc[ai][bj][m][n];
            }
    }
};
__device__ __forceinline__ void run_resid_gemm(const Fr& F, const bf16* A, const bf16* Bt, int K, bool with_ctx, const float* modl, int gidx, float coef) {
    { EpiResid E{F.X, modl, gidx, coef}; run_gemm(F, A, Bt, SEQ, D, K, E); }
    if (with_ctx) {
        pg8::Gemm g{A, Bt, MT, D, K, 256}; pg8::SplitKOrder S{64, 4, K / 256, F.G, F.bx};
        EpiSlab E{F.SLAB, modl, gidx, coef};
        int tid2 = F.tid; asm volatile("" : "+v"(tid2));
        pg8::gemm_phase<EpiSlab, pg8::SplitKOrder, false, false>(F.lds, g, S, E, tid2);
    }
}
__device__ __forceinline__ void xpose_item(const float* W, int K, int N, bf16* WT, int kb, int nb, int dst_row0, LAS float* scr, int lane) {
    const int k0 = 64 * kb, n0 = 32 * nb;
    float tv[32];
#pragma unroll
    for (int i = 0; i < 32; ++i) tv[i] = W[(size_t)(k0 + 2 * i + (lane >> 5)) * N + n0 + (lane & 31)];
#pragma unroll
    for (int i = 0; i < 32; ++i) scr[(2 * i + (lane >> 5)) * 33 + (lane & 31)] = tv[i];
    LDS_WAIT(); asm volatile("" ::: "memory");
    const int c = lane & 7;
#pragma unroll
    for (int j = 0; j < 4; ++j) { const int n = (lane >> 3) + 8 * j; const LAS float* s = scr + (8 * c) * 33 + n;
        u32x4 o; o.x = pk2(s[0 * 33], s[1 * 33]); o.y = pk2(s[2 * 33], s[3 * 33]); o.z = pk2(s[4 * 33], s[5 * 33]); o.w = pk2(s[6 * 33], s[7 * 33]);
        *(u32x4*)(WT + (size_t)(dst_row0 + n) * K + k0 + 8 * c) = o; }
    LDS_WAIT(); asm volatile("" ::: "memory");
}

__device__ __forceinline__ void ph_prologue(const Fr& F) {
    LAS float* scr = (LAS float*)(F.lds + F.wave * 16384);
    const int gw = F.bx * 8 + F.wave, NGW = F.G * 8;
    constexpr int C1 = 22528, C2 = C1 + 11264, C3 = C2 + 3104, C4 = C3 + 1024, C5 = C4 + 1536, C6 = C5 + 768, C7 = C6 + 192, C8 = C7 + 192, C9 = C8 + 768, C10 = C9 + 512;
    for (int it = gw; it < C10; it += NGW) {
        if (it < C1) { const int mat = it / 2816, r = it % 2816, kb = r / 176, nb = r % 176, n0 = 32 * nb, half = n0 / DFF, jj = n0 % DFF;
            xpose_item(F.ffn_w_in + (size_t)mat * D * 2 * DFF, D, 2 * DFF, F.WFI + (size_t)mat * 2 * DFF * D, kb, nb, (jj / 128) * 256 + half * 128 + (jj % 128), scr, F.lane); }
        else if (it < C2) { const int q = it - C1, mat = q / 1408, r = q % 1408; xpose_item(F.ffn_w_out + (size_t)mat * DFF * D, DFF, D, F.WFO + (size_t)mat * D * DFF, r / 32, r % 32, 32 * (r % 32), scr, F.lane); }
        else if (it < C3) { const int q = it - C2, mat = q / 1552, r = q % 1552; xpose_item(F.gla_w_in + (size_t)mat * D * 3104, D, 3104, F.WGI + (size_t)mat * GLA_NP * D, r / 97, r % 97, 32 * (r % 97), scr, F.lane); }
        else if (it < C4) { const int q = it - C3, mat = q / 512, r = q % 512; xpose_item(F.gla_w_out + (size_t)mat * D * D, D, D, F.WGO + (size_t)mat * D * D, r / 32, r % 32, 32 * (r % 32), scr, F.lane); }
        else if (it < C5) { const int r = it - C4; xpose_item(F.rg_w_in, D, 3072, F.WRI, r / 96, r % 96, 32 * (r % 96), scr, F.lane); }
        else if (it < C6) { const int r = it - C5; xpose_item(F.rg_w_out, 1536, D, F.WRO, r / 32, r % 32, 32 * (r % 32), scr, F.lane); }
        else if (it < C7) { const int q = it - C6, mat = q / 8, r = q % 8; xpose_item(F.rg_w_a + (size_t)mat * 16384, 128, 128, F.WRA + (size_t)mat * 16384, r / 4, r % 4, 32 * (r % 4), scr, F.lane); }
        else if (it < C8) { const int q = it - C7, mat = q / 8, r = q % 8; xpose_item(F.rg_w_x + (size_t)mat * 16384, 128, 128, F.WRX + (size_t)mat * 16384, r / 4, r % 4, 32 * (r % 4), scr, F.lane); }
        else if (it < C9) { const int r = it - C8; xpose_item(F.swa_w_qkv, D, 1536, F.WSQ, r / 48, r % 48, 32 * (r % 48), scr, F.lane); }
        else { const int r = it - C9; xpose_item(F.swa_w_out, D, D, F.WSO, r / 32, r % 32, 32 * (r % 32), scr, F.lane); }
    }
    const int gt = F.bx * 512 + F.tid, NGT = F.G * 512;
    for (int i = gt; i < 2 * 224 * (D / 8); i += NGT) { const int mat = i / (224 * 128), r = i % (224 * 128); *(u32x4*)(F.WGI + (size_t)mat * GLA_NP * D + (size_t)3104 * D + (size_t)r * 8) = (u32x4){0u, 0u, 0u, 0u}; }
    for (int i = gt; i < MT * (D / 4); i += NGT) { const f32x4 v = (i < SEQ * (D / 4)) ? ((const f32x4*)F.x)[i] : ((const f32x4*)F.ctx)[i - SEQ * (D / 4)]; ((f32x4*)F.X)[i] = v; }
    if (gt == 0) *(unsigned*)(F.ws + 512 * 1024) = 0u;
    if (gt < 4096) { const int id = gt >> 4, f = gt & 15; const float freq = powf(10000.0f, -(float)(2 * f) / 32.0f); const float ang = (float)id * freq;
        const double rev = (double)ang * 0.15915494309189535; const float rr = (float)(rev - rint(rev));
        F.ROPE[2 * gt] = __builtin_amdgcn_cosf(rr); F.ROPE[2 * gt + 1] = __builtin_amdgcn_sinf(rr); }
    __syncthreads();
    LAS f32x4* red = (LAS f32x4*)F.lds;
    for (int b = F.bx; b < 4 * 72; b += F.G) {
        const int li = b / 72, c0 = (b % 72) * 128 + 2 * F.lane;
        const float* wp = F.ada_w + (size_t)li * D * NMODV + (size_t)(F.wave * 128) * NMODV + c0;
        float a0 = 0.f, a1 = 0.f, b0 = 0.f, b1 = 0.f;
#pragma unroll 32
        for (int k = 0; k < 128; ++k) { const f32x2 w = *(const f32x2*)(wp + (size_t)k * NMODV); const float sl = siluf_(F.c[F.wave * 128 + k]), sc = siluf_(F.c_ctx[F.wave * 128 + k]);
            a0 += sl * w.x; a1 += sl * w.y; b0 += sc * w.x; b1 += sc * w.y; }
        red[F.wave * 64 + F.lane] = (f32x4){a0, a1, b0, b1};
        __syncthreads();
        if (F.wave == 0) { f32x4 s = red[F.lane];
#pragma unroll
            for (int w = 1; w < 8; ++w) s += red[w * 64 + F.lane];
            const f32x2 bb = *(const f32x2*)(F.ada_b + (size_t)li * NMODV + c0);
            *(f32x2*)(F.MOD + (size_t)(li * 2 + 0) * NMODV + c0) = (f32x2){s[0] + bb.x, s[1] + bb.y};
            *(f32x2*)(F.MOD + (size_t)(li * 2 + 1) * NMODV + c0) = (f32x2){s[2] + bb.x, s[3] + bb.y}; }
        __syncthreads();
    }
}

__device__ __forceinline__ void ph_norm(const Fr& F, int layer, int k, int mrows, int nks) {
    const float* g = F.norm_g + (size_t)(layer * 3 + k) * D;
    const int gw = F.bx * 8 + F.wave, NGW = F.G * 8;
    f32x4 gs[4], sh[4];
    { const float* mod = F.MOD + (size_t)(layer * 2) * NMODV; const float* shift = mod + (3 * k) * 1024; const float* scale = mod + (3 * k + 1) * 1024;
#pragma unroll
      for (int j = 0; j < 4; ++j) { const int col = 4 * (F.lane + 64 * j); gs[j] = *(const f32x4*)(g + col) * (*(const f32x4*)(scale + col) + 1.0f); sh[j] = *(const f32x4*)(shift + col); } }
    int m = gw;
    f32x4 v[4];
    if (m < mrows) { const f32x4* xr = (const f32x4*)(F.X + (size_t)m * D) + F.lane;
#pragma unroll
        for (int j = 0; j < 4; ++j) v[j] = xr[64 * j]; }
    while (m < mrows) {
        const int mn = m + NGW;
        f32x4 vn[4];
        if (mn < mrows) { const f32x4* xr = (const f32x4*)(F.X + (size_t)mn * D) + F.lane;
#pragma unroll
            for (int j = 0; j < 4; ++j) vn[j] = xr[64 * j]; }
        f32x4 gsr[4], shr[4];
#pragma unroll
        for (int j = 0; j < 4; ++j) { gsr[j] = gs[j]; shr[j] = sh[j]; }
        if (m >= SEQ) {
            const float* mod = F.MOD + (size_t)(layer * 2 + 1) * NMODV; const float* shift = mod + (3 * k) * 1024; const float* scale = mod + (3 * k + 1) * 1024;
#pragma unroll
            for (int j = 0; j < 4; ++j) { const int col = 4 * (F.lane + 64 * j); gsr[j] = *(const f32x4*)(g + col) * (*(const f32x4*)(scale + col) + 1.0f); shr[j] = *(const f32x4*)(shift + col); }
            if (nks > 0) {
                for (int ks = 0; ks < nks; ks += 4) {
                    f32x4 t[4][4];
#pragma unroll
                    for (int i = 0; i < 4; ++i) { const f32x4* sp = (const f32x4*)(F.SLAB + ((size_t)(ks + i < nks ? ks + i : ks) * 256 + (m - SEQ)) * D) + F.lane;
#pragma unroll
                        for (int j = 0; j < 4; ++j) t[i][j] = sp[64 * j]; }
#pragma unroll
                    for (int i = 0; i < 4; ++i) if (ks + i < nks) {
#pragma unroll
                        for (int j = 0; j < 4; ++j) v[j] += t[i][j]; }
                }
                f32x4* xw = (f32x4*)(F.X + (size_t)m * D) + F.lane;
#pragma unroll
                for (int j = 0; j < 4; ++j) xw[64 * j] = v[j];
            }
        }
        float ss = 0.f;
#pragma unroll
        for (int j = 0; j < 4; ++j) ss += (v[j].x * v[j].x + v[j].y * v[j].y) + (v[j].z * v[j].z + v[j].w * v[j].w);
        const float rstd = __builtin_amdgcn_rsqf(wave_sum(ss, F.lane) * (1.0f / D) + NORM_EPS);
        u32x2* o8 = (u32x2*)(F.XN + (size_t)m * D) + F.lane;
#pragma unroll
        for (int j = 0; j < 4; ++j) { const f32x4 y = v[j] * rstd * gsr[j] + shr[j]; u32x2 w; w.x = pk2(y[0], y[1]); w.y = pk2(y[2], y[3]); o8[64 * j] = w; }
#pragma unroll
        for (int j = 0; j < 4; ++j) v[j] = vn[j];
        m = mn;
    }
}
__device__ __forceinline__ void ph_final(const Fr& F) {
    const int gw = F.bx * 8 + F.wave, NGW = F.G * 8;
    for (int m = gw; m < SEQ; m += NGW) {
        const f32x4* xr = (const f32x4*)(F.X + (size_t)m * D) + F.lane;
        f32x4 v[4]; float ss = 0.f;
#pragma unroll
        for (int j = 0; j < 4; ++j) { v[j] = xr[64 * j]; ss += (v[j].x * v[j].x + v[j].y * v[j].y) + (v[j].z * v[j].z + v[j].w * v[j].w); }
        const float rstd = __builtin_amdgcn_rsqf(wave_sum(ss, F.lane) * (1.0f / D) + NORM_EPS);
        f32x4* o = (f32x4*)(F.out + (size_t)m * D) + F.lane;
#pragma unroll
        for (int j = 0; j < 4; ++j) { const f32x4 gg = *(const f32x4*)(F.final_g + 4 * (F.lane + 64 * j)); o[64 * j] = v[j] * rstd * gg; }
    }
}

__device__ __forceinline__ void gla_b_unit(const Fr& F, int j, int n, int h, int z) {
    LAS unsigned char* lds = F.lds;
    LAS float* sLR = (LAS float*)(lds);
    LAS float* sW = (LAS float*)(lds + 4096);
    LAS float* sB = (LAS float*)(lds + 12288);
    LAS float* sSeg = (LAS float*)(lds + 45056);
    LAS bf16* sVT = (LAS bf16*)(lds + 47104);
    LAS bf16* sKT = (LAS bf16*)(lds + 83968);
    const int tid = F.tid, row0 = 64 * n;
    float lrv[2], wav[4];
#pragma unroll
    for (int i = 0; i < 2; ++i) { const int ii = tid + 512 * i, t = ii >> 4, r = ii & 15; lrv[i] = F.LR[(size_t)(row0 + t) * 32 + z * 16 + r]; }
#pragma unroll
    for (int i = 0; i < 4; ++i) { const int ii = tid + 512 * i, r = ii >> 7, k = ii & 127; wav[i] = F.gla_w_a2[((size_t)(j * 2 + z) * 16 + r) * 512 + h * 128 + k]; }
    const int tS = tid >> 3, d0S = (tid & 7) * 16, rowS = row0 + tS, e0S = (tid & 7) * 32;
    const bf16* qpS = F.P + (size_t)rowS * 3072 + h * 128 + d0S;
    const bf16x8 q0 = *(const bf16x8*)qpS, q1 = *(const bf16x8*)(qpS + 8), k0 = *(const bf16x8*)(qpS + 512), k1 = *(const bf16x8*)(qpS + 520);
    const bf16* vpS = F.P + (size_t)rowS * 3072 + 1024 + h * 256 + e0S;
    const bf16x8 vv0 = *(const bf16x8*)vpS, vv1 = *(const bf16x8*)(vpS + 8), vv2 = *(const bf16x8*)(vpS + 16), vv3 = *(const bf16x8*)(vpS + 24);
    const float bias = F.gla_b_a[(size_t)(j * 2 + z) * 512 + h * 128 + (tid & 127)];
#pragma unroll
    for (int i = 0; i < 2; ++i) sLR[tid + 512 * i] = lrv[i];
#pragma unroll
    for (int i = 0; i < 4; ++i) sW[tid + 512 * i] = wav[i];
#pragma unroll
    for (int i = 0; i < 8; ++i) { sVT[(e0S + i) * 72 + tS] = (unsigned short)vv0[i]; sVT[(e0S + 8 + i) * 72 + tS] = (unsigned short)vv1[i]; sVT[(e0S + 16 + i) * 72 + tS] = (unsigned short)vv2[i]; sVT[(e0S + 24 + i) * 72 + tS] = (unsigned short)vv3[i]; }
    __syncthreads();
    {
        const int k = tid & 127, tq = tid >> 7;
        float wv[16];
#pragma unroll
        for (int r = 0; r < 16; ++r) wv[r] = sW[r * 128 + k];
        float gv[16];
#pragma unroll
        for (int i = 0; i < 16; ++i) { const int t = tq * 16 + i; float a = bias;
            const f32x4 l0 = *(const LAS f32x4*)(sLR + t * 16), l1 = *(const LAS f32x4*)(sLR + t * 16 + 4), l2 = *(const LAS f32x4*)(sLR + t * 16 + 8), l3 = *(const LAS f32x4*)(sLR + t * 16 + 12);
#pragma unroll
            for (int r = 0; r < 4; ++r) { a += l0[r] * wv[r]; a += l1[r] * wv[4 + r]; a += l2[r] * wv[8 + r]; a += l3[r] * wv[12 + r]; }
            gv[i] = logsigmoid_(a) * (1.0f / 16.0f); }
        float run = 0.f;
        if (z == 0) {
#pragma unroll
            for (int i = 0; i < 16; ++i) { run += gv[i]; gv[i] = run; }
        } else {
#pragma unroll
            for (int i = 15; i >= 0; --i) { run += gv[i]; gv[i] = run; }
        }
        sSeg[tq * 128 + k] = run;
        __syncthreads();
        float off = 0.f;
#pragma unroll
        for (int q = 0; q < 4; ++q) { const float sv = sSeg[q * 128 + k]; if (z == 0 ? (q < tq) : (q > tq)) off += sv; }
#pragma unroll
        for (int i = 0; i < 16; ++i) sB[(tq * 16 + i) * 128 + k] = gv[i] + off;
    }
    __syncthreads();
    const int tl = (z == 0) ? 63 : 0;
    {
        const int t = tid >> 3, d0 = (tid & 7) * 16, row = row0 + t;
        float qd[16], kn[16];
#pragma unroll
        for (int i = 0; i < 16; ++i) {
            const float bt = sB[t * 128 + d0 + i], bl = sB[tl * 128 + d0 + i];
            const float qv = bf2f((unsigned short)(i < 8 ? q0[i] : q1[i - 8])), kv = bf2f((unsigned short)(i < 8 ? k0[i] : k1[i - 8]));
            qd[i] = qv * __expf(bt); kn[i] = kv * __expf(-bt);
            sKT[(d0 + i) * 72 + t] = f2bf1(kv * __expf(bl - bt));
        }
        u32x4 w0, w1;
        w0.x = pk2(qd[0], qd[1]); w0.y = pk2(qd[2], qd[3]); w0.z = pk2(qd[4], qd[5]); w0.w = pk2(qd[6], qd[7]);
        w1.x = pk2(qd[8], qd[9]); w1.y = pk2(qd[10], qd[11]); w1.z = pk2(qd[12], qd[13]); w1.w = pk2(qd[14], qd[15]);
        bf16* qo = F.QD + ((size_t)z * MT + row) * 512 + h * 128 + d0; *(u32x4*)qo = w0; *(u32x4*)(qo + 8) = w1;
        w0.x = pk2(kn[0], kn[1]); w0.y = pk2(kn[2], kn[3]); w0.z = pk2(kn[4], kn[5]); w0.w = pk2(kn[6], kn[7]);
        w1.x = pk2(kn[8], kn[9]); w1.y = pk2(kn[10], kn[11]); w1.z = pk2(kn[12], kn[13]); w1.w = pk2(kn[14], kn[15]);
        bf16* ko = F.KN + ((size_t)z * MT + row) * 512 + h * 128 + d0; *(u32x4*)ko = w0; *(u32x4*)(ko + 8) = w1;
        if (tid < 128) F.DEC[(size_t)(z * NCH + n) * 512 + h * 128 + tid] = __expf(sB[tl * 128 + tid]);
    }
    __syncthreads();
    {
        const int r = F.lane & 15, q = F.lane >> 4, w = F.wave;
        const bf16x8 a0 = *(const LAS bf16x8*)(sKT + (w * 16 + r) * 72 + q * 8), a1 = *(const LAS bf16x8*)(sKT + (w * 16 + r) * 72 + 32 + q * 8);
        bf16* USp = F.US + ((size_t)(z * NCH + n) * 4 + h) * 32768;
#pragma unroll 4
        for (int et = 0; et < 16; ++et) {
            const bf16x8 b0 = *(const LAS bf16x8*)(sVT + (et * 16 + r) * 72 + q * 8), b1 = *(const LAS bf16x8*)(sVT + (et * 16 + r) * 72 + 32 + q * 8);
            f32x4 acc = {0.f, 0.f, 0.f, 0.f}; acc = mma(a0, b0, acc); acc = mma(a1, b1, acc);
            u32x2 o; o.x = pk2(acc[0], acc[1]); o.y = pk2(acc[2], acc[3]);
            *(u32x2*)(USp + (size_t)((et * 8 + w) * 16 + r) * 16 + 4 * q) = o;
        }
    }
    __syncthreads();
}
__device__ __forceinline__ void gla_scan(const Fr& F) {
    for (int idx = F.bx * 512 + F.tid; idx < 131072; idx += F.G * 512) {
        const int o2 = 2 * (idx & 16383), h = (idx >> 14) & 3, z = idx >> 16, dd = ((o2 >> 8) & 7) * 16 + (o2 & 15);
        float s0 = 0.f, s1 = 0.f;
        constexpr int NB = 13;
        unsigned uA[NB], uB[NB]; f32x2 dA[NB], dB[NB]; unsigned *pA[NB], *pB[NB];
#define GS_LOAD(U, Dc, P, s_) { _Pragma("unroll") for (int i = 0; i < NB; ++i) { const int ss = (s_) + i, n = z ? (NCH - 1 - ss) : (ss < 4 ? 256 + ss : ss - 4); \
            P[i] = (unsigned*)(F.US + ((size_t)(z * NCH + n) * 4 + h) * 32768 + o2); U[i] = *P[i]; \
            Dc[i] = *(const f32x2*)(F.DEC + (size_t)(z * NCH + n) * 512 + h * 128 + dd); } }
#define GS_PROC(U, Dc, P) { _Pragma("unroll") for (int i = 0; i < NB; ++i) { *P[i] = pk2(s0, s1); s0 = Dc[i].x * s0 + bflo(U[i]); s1 = Dc[i].y * s1 + bfhi(U[i]); } }
        GS_LOAD(uA, dA, pA, 0)
#pragma unroll 1
        for (int s = 0; s < NCH; s += 2 * NB) {
            GS_LOAD(uB, dB, pB, s + NB)
            GS_PROC(uA, dA, pA)
            if (s + 2 * NB < NCH) GS_LOAD(uA, dA, pA, s + 2 * NB)
            GS_PROC(uB, dB, pB)
        }
#undef GS_LOAD
#undef GS_PROC
    }
}
__device__ __forceinline__ void gla_d_unit(const Fr& F, int j, int n, int h) {
    LAS unsigned char* lds = F.lds;
    LAS bf16* sVT = (LAS bf16*)(lds);
    LAS bf16* sAtt = (LAS bf16*)(lds + 36864);
    LAS float* sSS = (LAS float*)(lds + 55296);
    const int tid = F.tid, row0 = 64 * n, r = F.lane & 15, q = F.lane >> 4, w = F.wave;
    bf16x8 usf[2][4][2];
#pragma unroll
    for (int z = 0; z < 2; ++z) { const bf16* USz = F.US + ((size_t)(z * NCH + n) * 4 + h) * 32768;
#pragma unroll
        for (int ks = 0; ks < 4; ++ks) { const int dt = 2 * ks + (q >> 1), dl = 8 * (q & 1);
            usf[z][ks][0] = *(const bf16x8*)(USz + (size_t)(((2 * w) * 8 + dt) * 16 + r) * 16 + dl); usf[z][ks][1] = *(const bf16x8*)(USz + (size_t)(((2 * w + 1) * 8 + dt) * 16 + r) * 16 + dl); } }
    {
        const int t = tid >> 3, e0 = (tid & 7) * 32;
        const bf16* vp = F.P + (size_t)(row0 + t) * 3072 + 1024 + h * 256 + e0;
#pragma unroll
        for (int c = 0; c < 4; ++c) { const bf16x8 vv = *(const bf16x8*)(vp + 8 * c);
#pragma unroll
            for (int i = 0; i < 8; ++i) sVT[(e0 + 8 * c + i) * 72 + t] = (unsigned short)vv[i]; }
    }
    {
        const int z = w >> 2, tt = w & 3;
        const bf16* qdp = F.QD + ((size_t)z * MT + row0 + tt * 16 + r) * 512 + h * 128 + 8 * q;
        bf16x8 bq[4];
#pragma unroll
        for (int ks = 0; ks < 4; ++ks) bq[ks] = *(const bf16x8*)(qdp + 32 * ks);
        const int t = tt * 16 + r;
#pragma unroll
        for (int st = 0; st < 4; ++st) {
            const bf16* knp = F.KN + ((size_t)z * MT + row0 + st * 16 + r) * 512 + h * 128 + 8 * q;
            f32x4 acc = {0.f, 0.f, 0.f, 0.f};
#pragma unroll
            for (int ks = 0; ks < 4; ++ks) acc = mma(*(const bf16x8*)(knp + 32 * ks), bq[ks], acc);
#pragma unroll
            for (int jj = 0; jj < 4; ++jj) { const int s = st * 16 + 4 * q + jj; const bool keep = (z == 0) ? (s <= t) : (s >= t); if (!keep) acc[jj] = 0.f; }
            u32x2 o; o.x = pk2(acc[0], acc[1]); o.y = pk2(acc[2], acc[3]);
            *(LAS u32x2*)(sAtt + (z * 64 + t) * 72 + st * 16 + 4 * q) = o;
        }
    }
    __syncthreads();
    f32x4 acc[2][4];
#pragma unroll
    for (int ei = 0; ei < 2; ++ei)
#pragma unroll
        for (int tt = 0; tt < 4; ++tt) acc[ei][tt] = (f32x4){0.f, 0.f, 0.f, 0.f};
#pragma unroll
    for (int z = 0; z < 2; ++z) {
#pragma unroll
        for (int ks = 0; ks < 2; ++ks) {
            const bf16x8 a0 = *(const LAS bf16x8*)(sVT + (32 * w + r) * 72 + ks * 32 + 8 * q), a1 = *(const LAS bf16x8*)(sVT + (32 * w + 16 + r) * 72 + ks * 32 + 8 * q);
#pragma unroll
            for (int tt = 0; tt < 4; ++tt) { const bf16x8 b = *(const LAS bf16x8*)(sAtt + (z * 64 + tt * 16 + r) * 72 + ks * 32 + 8 * q);
                acc[0][tt] = mma(a0, b, acc[0][tt]); acc[1][tt] = mma(a1, b, acc[1][tt]); }
        }
        const bf16* QDz = F.QD + ((size_t)z * MT + row0 + r) * 512 + h * 128 + 8 * q;
#pragma unroll
        for (int ks = 0; ks < 4; ++ks) {
            const bf16x8 a0 = usf[z][ks][0], a1 = usf[z][ks][1];
#pragma unroll
            for (int tt = 0; tt < 4; ++tt) { const bf16x8 b = *(const bf16x8*)(QDz + (size_t)(tt * 16) * 512 + ks * 32);
                acc[0][tt] = mma(a0, b, acc[0][tt]); acc[1][tt] = mma(a1, b, acc[1][tt]); }
        }
    }
#pragma unroll
    for (int tt = 0; tt < 4; ++tt) {
        float ss = 0.f;
#pragma unroll
        for (int ei = 0; ei < 2; ++ei)
#pragma unroll
            for (int jj = 0; jj < 4; ++jj) ss += acc[ei][tt][jj] * acc[ei][tt][jj];
        ss += shx(ss, 16, F.lane); ss += shx(ss, 32, F.lane);
        if (q == 0) sSS[w * 64 + tt * 16 + r] = ss;
    }
    __syncthreads();
#pragma unroll
    for (int tt = 0; tt < 4; ++tt) {
        float tot = 0.f;
#pragma unroll
        for (int ww = 0; ww < 8; ++ww) tot += sSS[ww * 64 + tt * 16 + r];
        const float rstd = __builtin_amdgcn_rsqf(tot * (1.0f / 256.0f) + NORM_EPS);
        const size_t row = (size_t)(row0 + tt * 16 + r);
#pragma unroll
        for (int ei = 0; ei < 2; ++ei) {
            const int e = 32 * w + 16 * ei + 4 * q;
            const f32x4 g4 = *(const f32x4*)(F.gla_norm_g + (size_t)j * 256 + e);
            const u32x2 og = *(const u32x2*)(F.P + row * 3072 + 2048 + h * 256 + e);
            const float o0 = acc[ei][tt][0] * rstd * g4[0] * siluf_(bflo(og.x)), o1 = acc[ei][tt][1] * rstd * g4[1] * siluf_(bfhi(og.x));
            const float o2 = acc[ei][tt][2] * rstd * g4[2] * siluf_(bflo(og.y)), o3 = acc[ei][tt][3] * rstd * g4[3] * siluf_(bfhi(og.y));
            u32x2 o; o.x = pk2(o0, o1); o.y = pk2(o2, o3);
            *(u32x2*)(F.OB + row * 1024 + h * 256 + e) = o;
        }
    }
    __syncthreads();
}

__device__ __forceinline__ void rg_unit(const Fr& F, int n, int nb, int mode, int buf) {
    LAS unsigned char* lds = F.lds;
    LAS bf16* sXC = (LAS bf16*)(lds + buf * 17408);
    const int tid = F.tid, row0 = 64 * n, w = F.wave;
    LAS float* sA = (LAS float*)(lds + 34816 + w * 12288);
    LAS float* sU = sA + 1024;
    LAS float* sHS = sA + 2048;
    const int lo = (n >= 256) ? SEQ : 0, hi = (n >= 256) ? MT : SEQ;
    {
        const int cc = tid & 127, tq = tid >> 7, c = 128 * nb + cc;
        const float w0 = F.rg_conv_w[0 * 1536 + c], w1 = F.rg_conv_w[1 * 1536 + c], w2 = F.rg_conv_w[2 * 1536 + c], w3 = F.rg_conv_w[3 * 1536 + c], cb = F.rg_conv_b[c];
        const int tb = row0 + tq * 16;
        float xm2, xm1, x0, xp1;
        { const int r = tb - 2; xm2 = (r >= lo && r < hi) ? bf2f(F.XR[(size_t)r * 1536 + c]) : 0.f; }
        { const int r = tb - 1; xm1 = (r >= lo && r < hi) ? bf2f(F.XR[(size_t)r * 1536 + c]) : 0.f; }
        x0 = bf2f(F.XR[(size_t)tb * 1536 + c]);
#pragma unroll
        for (int i = 0; i < 16; ++i) {
            const int r = tb + i + 1; xp1 = (r < hi) ? bf2f(F.XR[(size_t)r * 1536 + c]) : 0.f;
            const float xc = cb + w0 * xm2 + w1 * xm1 + w2 * x0 + w3 * xp1;
            sXC[(tq * 16 + i) * 136 + cc] = f2bf1(xc);
            xm2 = xm1; xm1 = x0; x0 = xp1;
        }
    }
    __syncthreads();
    const int r = F.lane & 15, q = F.lane >> 4;
    const int c16 = 128 * nb + 16 * w;
#pragma unroll 1
    for (int z = 0; z < 2; ++z) {
        {
            const bf16* wa = F.WRA + ((size_t)(z * 12 + nb) * 128 + 16 * w + r) * 128 + 8 * q;
            const bf16* wx = F.WRX + ((size_t)(z * 12 + nb) * 128 + 16 * w + r) * 128 + 8 * q;
            f32x4 ra[4], ia[4];
#pragma unroll
            for (int tt = 0; tt < 4; ++tt) { ra[tt] = (f32x4){0.f, 0.f, 0.f, 0.f}; ia[tt] = (f32x4){0.f, 0.f, 0.f, 0.f}; }
#pragma unroll
            for (int ks = 0; ks < 4; ++ks) {
                const bf16x8 ar = *(const bf16x8*)(wa + 32 * ks), ai = *(const bf16x8*)(wx + 32 * ks);
#pragma unroll
                for (int tt = 0; tt < 4; ++tt) { const bf16x8 b = *(const LAS bf16x8*)(sXC + (tt * 16 + r) * 136 + ks * 32 + 8 * q); ra[tt] = mma(ar, b, ra[tt]); ia[tt] = mma(ai, b, ia[tt]); }
            }
            const int cl = 16 * w + 4 * q, c4 = 128 * nb + cl;
            const f32x4 ba = *(const f32x4*)(F.rg_b_a + z * 1536 + c4), bx = *(const f32x4*)(F.rg_b_x + z * 1536 + c4), lam = *(const f32x4*)(F.rg_lam + z * 1536 + c4);
            f32x4 coef;
#pragma unroll
            for (int jj = 0; jj < 4; ++jj) coef[jj] = -8.0f * softplus_(-lam[jj]);
#pragma unroll
            for (int tt = 0; tt < 4; ++tt) {
                const int t = tt * 16 + r;
                const u32x2 xw = *(const LAS u32x2*)(sXC + t * 136 + cl);
                const float xc[4] = {bflo(xw.x), bfhi(xw.x), bflo(xw.y), bfhi(xw.y)};
                f32x4 av, uv, lav;
#pragma unroll
                for (int jj = 0; jj < 4; ++jj) {
                    const float rr = sigmoidf_(ra[tt][jj] + ba[jj]), ii = sigmoidf_(ia[tt][jj] + bx[jj]);
                    const float la = coef[jj] * rr, x2 = 2.0f * la;
                    const float a = __expf(la);
                    const float ser = -x2 * (1.0f + x2 * (0.5f + x2 * (0.16666667f + x2 * (0.041666668f + x2 * 0.008333334f))));
                    const float om = (x2 > -0.25f) ? ser : (1.0f - a * a);
                    av[jj] = a; uv[jj] = __builtin_amdgcn_sqrtf(om) * (ii * xc[jj]); lav[jj] = la;
                }
                *(LAS f32x4*)(sA + t * 16 + 4 * q) = av; *(LAS f32x4*)(sU + t * 16 + 4 * q) = uv;
                { const size_t go = (((size_t)(z * NCH + n) * 12 + nb) * 8 + w) * 1024 + (size_t)t * 16 + 4 * q; u32x2 lw, uw; lw.x = pk2(lav[0], lav[1]); lw.y = pk2(lav[2], lav[3]); uw.x = pk2(uv[0], uv[1]); uw.y = pk2(uv[2], uv[3]);
                  *(u32x2*)(F.LAg + go) = lw; *(u32x2*)(F.UUg + go) = uw; }
            }
        }
        asm volatile("s_waitcnt lgkmcnt(0)" ::: "memory");
        {
            const int cl = F.lane & 15, seg = F.lane >> 4, c = c16 + cl;
            float Pp = 1.f, Hh = 0.f;
            if (z == 0) {
#pragma unroll
                for (int i = 0; i < 16; ++i) { const int t = seg * 16 + i; const float a = sA[t * 16 + cl], u = sU[t * 16 + cl]; Hh = a * Hh + u; Pp *= a; } }
            else {
#pragma unroll
                for (int i = 15; i >= 0; --i) { const int t = seg * 16 + i; const float a = sA[t * 16 + cl], u = sU[t * 16 + cl]; Hh = a * Hh + u; Pp *= a; } }
            float sp[4], sh[4];
            sp[0] = Pp; sh[0] = Hh;
            sp[1] = shx(Pp, 16, F.lane); sh[1] = shx(Hh, 16, F.lane);
            sp[2] = shx(Pp, 32, F.lane); sh[2] = shx(Hh, 32, F.lane);
            sp[3] = shx(Pp, 48, F.lane); sh[3] = shx(Hh, 48, F.lane);
            if (mode == 0) {
                float Pt = 1.f, Ht = 0.f;
#pragma unroll
                for (int s2 = 0; s2 < 4; ++s2) { const int sg = (z == 0) ? s2 : 3 - s2;
                    float p_ = sp[0], h_ = sh[0];
#pragma unroll
                    for (int x = 1; x < 4; ++x) if ((seg ^ x) == sg) { p_ = sp[x]; h_ = sh[x]; }
                    Ht = p_ * Ht + h_; Pt *= p_; }
                if (seg == 0) { F.AP[(size_t)(z * NCH + n) * 1536 + c] = Pt; F.HE[(size_t)(z * NCH + n) * 1536 + c] = Ht; }
            } else {
                float hh = F.CIN[(size_t)(z * NCH + n) * 1536 + c];
#pragma unroll
                for (int s2 = 0; s2 < 4; ++s2) { const int sg = (z == 0) ? s2 : 3 - s2; const bool prior = (z == 0) ? (sg < seg) : (sg > seg);
                    float p_ = sp[0], h_ = sh[0];
#pragma unroll
                    for (int x = 1; x < 4; ++x) if ((seg ^ x) == sg) { p_ = sp[x]; h_ = sh[x]; }
                    if (prior) hh = p_ * hh + h_; }
                if (z == 0) {
#pragma unroll
                    for (int i = 0; i < 16; ++i) { const int t = seg * 16 + i; hh = sA[t * 16 + cl] * hh + sU[t * 16 + cl]; sHS[t * 16 + cl] = hh; } }
                else {
#pragma unroll
                    for (int i = 15; i >= 0; --i) { const int t = seg * 16 + i; hh = sA[t * 16 + cl] * hh + sU[t * 16 + cl]; sHS[t * 16 + cl] += hh; } }
            }
        }
        asm volatile("s_waitcnt lgkmcnt(0)" ::: "memory");
    }
    if (mode == 1) {
        const int t = F.lane; const size_t row = (size_t)(row0 + t);
        const u32x4 g0 = *(const u32x4*)(F.GG + row * 1536 + c16), g1 = *(const u32x4*)(F.GG + row * 1536 + c16 + 8);
        const f32x4 h0 = *(const LAS f32x4*)(sHS + t * 16), h1 = *(const LAS f32x4*)(sHS + t * 16 + 4), h2 = *(const LAS f32x4*)(sHS + t * 16 + 8), h3 = *(const LAS f32x4*)(sHS + t * 16 + 12);
        u32x4 o0, o1;
        o0.x = pk2(h0[0] * bflo(g0.x), h0[1] * bfhi(g0.x)); o0.y = pk2(h0[2] * bflo(g0.y), h0[3] * bfhi(g0.y)); o0.z = pk2(h1[0] * bflo(g0.z), h1[1] * bfhi(g0.z)); o0.w = pk2(h1[2] * bflo(g0.w), h1[3] * bfhi(g0.w));
        o1.x = pk2(h2[0] * bflo(g1.x), h2[1] * bfhi(g1.x)); o1.y = pk2(h2[2] * bflo(g1.y), h2[3] * bfhi(g1.y)); o1.z = pk2(h3[0] * bflo(g1.z), h3[1] * bfhi(g1.z)); o1.w = pk2(h3[2] * bflo(g1.w), h3[3] * bfhi(g1.w));
        *(u32x4*)(F.OB + row * 1536 + c16) = o0; *(u32x4*)(F.OB + row * 1536 + c16 + 8) = o1;
        asm volatile("s_waitcnt lgkmcnt(0)" ::: "memory");
    }
}
template <int CTRL, int RMASK> __device__ __forceinline__ float dppf(float oldv, float src) {
    return __builtin_bit_cast(float, __builtin_amdgcn_update_dpp(__builtin_bit_cast(int, oldv), __builtin_bit_cast(int, src), CTRL, RMASK, 0xf, false)); }
template <int CTRL, int RMASK> __device__ __forceinline__ void scan_step(float& P, float& H) {
    const float Pp = dppf<CTRL, RMASK>(1.0f, P), Hp = dppf<CTRL, RMASK>(0.0f, H);
    H = P * Hp + H; P = P * Pp; }
__device__ __forceinline__ void rg_unit1(const Fr& F, int n, int nb) {
    const int row0 = 64 * n, c16 = 128 * nb + 16 * F.wave, lane = F.lane;
    float hs[16];
#pragma unroll
    for (int z = 0; z < 2; ++z) {
        const int t = z ? 63 - lane : lane;
        const size_t go = (((size_t)(z * NCH + n) * 12 + nb) * 8 + F.wave) * 1024 + (size_t)t * 16;
        const u32x4 l0 = *(const u32x4*)(F.LAg + go), l1 = *(const u32x4*)(F.LAg + go + 8), u0 = *(const u32x4*)(F.UUg + go), u1 = *(const u32x4*)(F.UUg + go + 8);
        const float* cp = F.CIN + (size_t)(z * NCH + n) * 1536 + c16;
        const f32x4 ci0 = *(const f32x4*)cp, ci1 = *(const f32x4*)(cp + 4), ci2 = *(const f32x4*)(cp + 8), ci3 = *(const f32x4*)(cp + 12);
        float P[16], H[16], ci[16];
#pragma unroll
        for (int k = 0; k < 4; ++k) { P[2 * k] = __expf(bflo(l0[k])); P[2 * k + 1] = __expf(bfhi(l0[k])); P[8 + 2 * k] = __expf(bflo(l1[k])); P[8 + 2 * k + 1] = __expf(bfhi(l1[k]));
            H[2 * k] = bflo(u0[k]); H[2 * k + 1] = bfhi(u0[k]); H[8 + 2 * k] = bflo(u1[k]); H[8 + 2 * k + 1] = bfhi(u1[k]);
            ci[k] = ci0[k]; ci[4 + k] = ci1[k]; ci[8 + k] = ci2[k]; ci[12 + k] = ci3[k]; }
#pragma unroll
        for (int ch = 0; ch < 16; ++ch) {
            float p = P[ch], h = H[ch];
            scan_step<0x111, 0xf>(p, h); scan_step<0x112, 0xf>(p, h); scan_step<0x114, 0xf>(p, h); scan_step<0x118, 0xf>(p, h);
            scan_step<0x142, 0xa>(p, h); scan_step<0x143, 0xc>(p, h);
            const float hv = p * ci[ch] + h;
            if (z == 0) hs[ch] = hv;
            else hs[ch] += __builtin_bit_cast(float, __builtin_amdgcn_ds_bpermute((63 - lane) << 2, __builtin_bit_cast(int, hv)));
        }
    }
    const size_t ro = (size_t)(row0 + lane) * 1536 + c16;
    const u32x4 g0 = *(const u32x4*)(F.GG + ro), g1 = *(const u32x4*)(F.GG + ro + 8);
    u32x4 o0, o1;
    o0.x = pk2(hs[0] * bflo(g0.x), hs[1] * bfhi(g0.x)); o0.y = pk2(hs[2] * bflo(g0.y), hs[3] * bfhi(g0.y)); o0.z = pk2(hs[4] * bflo(g0.z), hs[5] * bfhi(g0.z)); o0.w = pk2(hs[6] * bflo(g0.w), hs[7] * bfhi(g0.w));
    o1.x = pk2(hs[8] * bflo(g1.x), hs[9] * bfhi(g1.x)); o1.y = pk2(hs[10] * bflo(g1.y), hs[11] * bfhi(g1.y)); o1.z = pk2(hs[12] * bflo(g1.z), hs[13] * bfhi(g1.z)); o1.w = pk2(hs[14] * bflo(g1.w), hs[15] * bfhi(g1.w));
    *(u32x4*)(F.OB + ro) = o0; *(u32x4*)(F.OB + ro + 8) = o1;
}
__device__ __forceinline__ void rg_carry(const Fr& F) {
    const int lane = F.lane;
    for (int sq = F.bx * 8 + F.wave; sq < 3072; sq += F.G * 8) {
        const int z = sq / 1536, c = sq % 1536;
        float ap[5], he[5]; size_t off[5];
        float Pl = 1.f, Hl = 0.f;
#pragma unroll
        for (int i = 0; i < 5; ++i) { const int ss = 5 * lane + i; const bool ok = ss < NCH; const int sc = ok ? ss : 0, n = z ? (NCH - 1 - sc) : (sc < 4 ? 256 + sc : sc - 4);
            off[i] = (size_t)(z * NCH + n) * 1536 + c; ap[i] = ok ? F.AP[off[i]] : 1.f; he[i] = ok ? F.HE[off[i]] : 0.f; }
#pragma unroll
        for (int i = 0; i < 5; ++i) { Hl = ap[i] * Hl + he[i]; Pl *= ap[i]; }
        float Pi = Pl, Hi = Hl;
#pragma unroll
        for (int o = 1; o < 64; o <<= 1) {
            const int src = lane - o;
            const float Pp = __builtin_bit_cast(float, __builtin_amdgcn_ds_bpermute((src < 0 ? lane : src) << 2, __builtin_bit_cast(int, Pi)));
            const float Hp = __builtin_bit_cast(float, __builtin_amdgcn_ds_bpermute((src < 0 ? lane : src) << 2, __builtin_bit_cast(int, Hi)));
            if (src >= 0) { Hi = Pi * Hp + Hi; Pi = Pi * Pp; }
        }
        float hh = __builtin_bit_cast(float, __builtin_amdgcn_ds_bpermute((lane > 0 ? lane - 1 : 0) << 2, __builtin_bit_cast(int, Hi)));
        if (lane == 0) hh = 0.f;
#pragma unroll
        for (int i = 0; i < 5; ++i) { if (5 * lane + i < NCH) F.CIN[off[i]] = hh; hh = ap[i] * hh + he[i]; }
    }
}

__device__ __forceinline__ void swa_unit(const Fr& F, int qb, int kvh) {
    LAS unsigned char* lds = F.lds;
    LAS bf16* sK = (LAS bf16*)(lds);
    LAS bf16* sVT = (LAS bf16*)(lds + 9216);
    const int tid = F.tid, row0 = 64 * qb, r = F.lane & 15, q = F.lane >> 4, w = F.wave;
    const bool is_ctx = qb >= 256;
    const int hq = kvh * 4 + (w >> 1), qoff = 32 * (w & 1);
    bf16x8 bq[2][2];
#pragma unroll
    for (int qt = 0; qt < 2; ++qt)
#pragma unroll
        for (int ks = 0; ks < 2; ++ks) bq[qt][ks] = *(const bf16x8*)(F.QKV + (size_t)(row0 + qoff + 16 * qt + r) * 1536 + hq * 64 + 32 * ks + 8 * q);
    float mrun[2], lrun[2];
    f32x4 o[4][2];
    { const float sk = F.swa_sink[hq]; mrun[0] = sk; mrun[1] = sk; lrun[0] = (q == 0) ? 1.f : 0.f; lrun[1] = lrun[0]; }
#pragma unroll
    for (int dt = 0; dt < 4; ++dt) { o[dt][0] = (f32x4){0.f, 0.f, 0.f, 0.f}; o[dt][1] = (f32x4){0.f, 0.f, 0.f, 0.f}; }
    const int ntiles = is_ctx ? 4 : 9;
#pragma unroll 1
    for (int ti = 0; ti < ntiles; ++ti) {
        int krow0; bool local;
        if (ti < 4) { krow0 = SEQ + 64 * ti; local = false; }
        else { krow0 = row0 - 128 + 64 * (ti - 4); local = true; if (krow0 < 0 || krow0 >= SEQ) continue; }
        __syncthreads();
        {
            const int key = tid >> 3, d0 = (tid & 7) * 8;
            const bf16* kp = F.QKV + (size_t)(krow0 + key) * 1536 + 1024 + kvh * 64 + d0;
            *(LAS bf16x8*)(sK + key * 72 + d0) = *(const bf16x8*)kp;
            const bf16x8 vv = *(const bf16x8*)(kp + 256);
#pragma unroll
            for (int i = 0; i < 8; ++i) sVT[(d0 + i) * 72 + key] = (unsigned short)vv[i];
        }
        __syncthreads();
        f32x4 st[4][2];
#pragma unroll
        for (int kt = 0; kt < 4; ++kt) {
            const bf16x8 a0 = *(const LAS bf16x8*)(sK + (16 * kt + r) * 72 + 8 * q), a1 = *(const LAS bf16x8*)(sK + (16 * kt + r) * 72 + 32 + 8 * q);
#pragma unroll
            for (int qt = 0; qt < 2; ++qt) { f32x4 a = {0.f, 0.f, 0.f, 0.f}; a = mma(a0, bq[qt][0], a); a = mma(a1, bq[qt][1], a); st[kt][qt] = a; }
        }
        if (local) {
#pragma unroll
            for (int kt = 0; kt < 4; ++kt)
#pragma unroll
                for (int qt = 0; qt < 2; ++qt)
#pragma unroll
                    for (int jj = 0; jj < 4; ++jj) { const int kpos = krow0 + 16 * kt + 4 * q + jj, qpos = row0 + qoff + 16 * qt + r; const int dd = kpos - qpos; if (dd > 128 || dd < -128) st[kt][qt][jj] = -1e30f; }
        }
#pragma unroll
        for (int qt = 0; qt < 2; ++qt) {
            float tm = -1e30f;
#pragma unroll
            for (int kt = 0; kt < 4; ++kt)
#pragma unroll
                for (int jj = 0; jj < 4; ++jj) tm = fmaxf(tm, st[kt][qt][jj]);
            tm = fmaxf(tm, shx(tm, 16, F.lane)); tm = fmaxf(tm, shx(tm, 32, F.lane));
            const float mn = fmaxf(mrun[qt], tm), alpha = __expf(mrun[qt] - mn);
            mrun[qt] = mn; float ls = lrun[qt] * alpha;
#pragma unroll
            for (int dt = 0; dt < 4; ++dt) o[dt][qt] *= alpha;
#pragma unroll
            for (int kt = 0; kt < 4; ++kt)
#pragma unroll
                for (int jj = 0; jj < 4; ++jj) { const float p = __expf(st[kt][qt][jj] - mn); ls += p; st[kt][qt][jj] = p; }
            lrun[qt] = ls;
        }
#pragma unroll
        for (int kp = 0; kp < 2; ++kp) {
            bf16x8 bp[2];
#pragma unroll
            for (int qt = 0; qt < 2; ++qt) {
                u32x4 pw; pw.x = pk2(st[2 * kp][qt][0], st[2 * kp][qt][1]); pw.y = pk2(st[2 * kp][qt][2], st[2 * kp][qt][3]);
                pw.z = pk2(st[2 * kp + 1][qt][0], st[2 * kp + 1][qt][1]); pw.w = pk2(st[2 * kp + 1][qt][2], st[2 * kp + 1][qt][3]);
                bp[qt] = __builtin_bit_cast(bf16x8, pw);
            }
#pragma unroll
            for (int dt = 0; dt < 4; ++dt) {
                const u32x2 v0 = *(const LAS u32x2*)(sVT + (16 * dt + r) * 72 + 32 * kp + 4 * q), v1 = *(const LAS u32x2*)(sVT + (16 * dt + r) * 72 + 32 * kp + 16 + 4 * q);
                u32x4 vw; vw.x = v0.x; vw.y = v0.y; vw.z = v1.x; vw.w = v1.y;
                const bf16x8 av = __builtin_bit_cast(bf16x8, vw);
                o[dt][0] = mma(av, bp[0], o[dt][0]); o[dt][1] = mma(av, bp[1], o[dt][1]);
            }
        }
    }
#pragma unroll
    for (int qt = 0; qt < 2; ++qt) {
        float lt = lrun[qt]; lt += shx(lt, 16, F.lane); lt += shx(lt, 32, F.lane);
        const float inv = __builtin_amdgcn_rcpf(lt);
        bf16* op = F.OB + (size_t)(row0 + qoff + 16 * qt + r) * 1024 + hq * 64 + 4 * q;
#pragma unroll
        for (int dt = 0; dt < 4; ++dt) { const f32x4 v = o[dt][qt] * inv; u32x2 ow; ow.x = pk2(v[0], v[1]); ow.y = pk2(v[2], v[3]); *(u32x2*)(op + 16 * dt) = ow; }
    }
    __syncthreads();
}


#define CAS __attribute__((address_space(4)))
__device__ __forceinline__ const float* ld_in(const CAS unsigned char* kargp, int k) { asm volatile("" : "+s"(k)); return *(const float* const CAS*)(kargp + (size_t)k * 8); }
__device__ __forceinline__ unsigned char* ws_at(unsigned char* ws, unsigned long long off) { asm volatile("" : "+s"(off)); return ws + off; }
__device__ __forceinline__ void fill_ptrs(Fr& F, const CAS unsigned char* kargp) {
    F.x = ld_in(kargp, 0); F.c = ld_in(kargp, 1); F.ctx = ld_in(kargp, 2); F.c_ctx = ld_in(kargp, 3); F.ada_w = ld_in(kargp, 4); F.ada_b = ld_in(kargp, 5); F.norm_g = ld_in(kargp, 6); F.final_g = ld_in(kargp, 7);
    F.ffn_w_in = ld_in(kargp, 8); F.ffn_w_out = ld_in(kargp, 9); F.gla_w_in = ld_in(kargp, 10); F.gla_w_a2 = ld_in(kargp, 11); F.gla_b_a = ld_in(kargp, 12); F.gla_norm_g = ld_in(kargp, 13); F.gla_w_out = ld_in(kargp, 14);
    F.rg_w_in = ld_in(kargp, 15); F.rg_conv_w = ld_in(kargp, 16); F.rg_conv_b = ld_in(kargp, 17); F.rg_w_a = ld_in(kargp, 18); F.rg_b_a = ld_in(kargp, 19); F.rg_w_x = ld_in(kargp, 20); F.rg_b_x = ld_in(kargp, 21);
    F.rg_lam = ld_in(kargp, 22); F.rg_w_out = ld_in(kargp, 23); F.swa_w_qkv = ld_in(kargp, 24); F.swa_sink = ld_in(kargp, 25); F.swa_w_out = ld_in(kargp, 26);
    F.out = (float*)ld_in(kargp, 27); unsigned char* ws = (unsigned char*)ld_in(kargp, 28); F.ws = ws;
    F.MOD = (float*)ws_at(ws, WS_MOD); F.ROPE = (float*)ws_at(ws, WS_ROPE); F.X = (float*)ws_at(ws, WS_X);
    F.WFI = (bf16*)ws_at(ws, WS_WFI); F.WFO = (bf16*)ws_at(ws, WS_WFO); F.WGI = (bf16*)ws_at(ws, WS_WGI); F.WGO = (bf16*)ws_at(ws, WS_WGO); F.WRI = (bf16*)ws_at(ws, WS_WRI); F.WRO = (bf16*)ws_at(ws, WS_WRO);
    F.WRA = (bf16*)ws_at(ws, WS_WRA); F.WRX = (bf16*)ws_at(ws, WS_WRX); F.WSQ = (bf16*)ws_at(ws, WS_WSQ); F.WSO = (bf16*)ws_at(ws, WS_WSO);
    F.XN = (bf16*)ws_at(ws, WS_XN); F.OB = (bf16*)ws_at(ws, WS_OB); F.H = (bf16*)ws_at(ws, WS_AR + A_H);
    F.P = (bf16*)ws_at(ws, WS_AR + A_P); F.LR = (float*)ws_at(ws, WS_AR + A_LR); F.QD = (bf16*)ws_at(ws, WS_AR + A_QD); F.KN = (bf16*)ws_at(ws, WS_AR + A_KN); F.DEC = (float*)ws_at(ws, WS_AR + A_DEC); F.US = (bf16*)ws_at(ws, WS_AR + A_US);
    F.GG = (bf16*)ws_at(ws, WS_AR + A_GG); F.XR = (bf16*)ws_at(ws, WS_AR + A_XR); F.AP = (float*)ws_at(ws, WS_AR + A_AP); F.HE = (float*)ws_at(ws, WS_AR + A_HE); F.CIN = (float*)ws_at(ws, WS_AR + A_CIN); F.LAg = (bf16*)ws_at(ws, WS_AR + A_LA); F.UUg = (bf16*)ws_at(ws, WS_AR + A_UU);
    F.QKV = (bf16*)ws_at(ws, WS_AR + A_QKV); F.SLAB = (float*)ws_at(ws, WS_SLAB);
}

#ifdef DBG_CHECK
__device__ __forceinline__ bool bad16(unsigned short u) { return (u & 0x7f80u) == 0x7f80u; }
__device__ __forceinline__ bool bad32(unsigned u) { return (u & 0x7f800000u) == 0x7f800000u; }
__device__ __forceinline__ void dbg_scan(const Fr& F, unsigned* flag) {
    const size_t gt = (size_t)F.bx * 512 + F.tid, NGT = (size_t)F.G * 512;
    unsigned m = 0;
    for (size_t i = gt; i < (size_t)MT * 32; i += NGT) if (bad32(((const unsigned*)F.LR)[i])) m |= 1u;
    for (size_t i = gt; i < (size_t)MT * 3072; i += NGT) if (bad16(F.P[i])) m |= 2u;
    for (size_t i = gt; i < (size_t)2 * MT * 512; i += NGT) { if (bad16(F.QD[i])) m |= 4u; if (bad16(F.KN[i])) m |= 8u; }
    for (size_t i = gt; i < (size_t)2 * NCH * 4 * 32768; i += NGT) if (bad16(F.US[i])) m |= 16u;
    for (size_t i = gt; i < (size_t)MT * 1024; i += NGT) if (bad16(F.OB[i])) m |= 32u;
    if (m) atomicOr(flag, m);
}
#endif

#define XB_TMO      128
#define XB_XCNT(j)  (256  + 64 * (j))
#define XB_XSUB(j)  (1280 + 64 * (j))
#define XB_XGEN(j)  (2304 + 64 * (j))
#define XB_TOP      3328
#define XB_TOPGEN   3392
#define XCD_BAR_WORDS 3456
#define XB_SPIN_CAP (1u << 18)

__device__ __forceinline__ unsigned xb_ld(unsigned* p)              { return __hip_atomic_load(p, __ATOMIC_RELAXED, __HIP_MEMORY_SCOPE_AGENT); }
__device__ __forceinline__ unsigned xb_add(unsigned* p, unsigned v) { return __hip_atomic_fetch_add(p, v, __ATOMIC_RELAXED, __HIP_MEMORY_SCOPE_AGENT); }
__device__ __forceinline__ unsigned xb_xcc_id() { return (unsigned)__builtin_amdgcn_s_getreg((3 << 11) | 20) & 0xFu; }
#define XB_SPIN(cond, bar) do { unsigned _sp = 0; while (cond) { __builtin_amdgcn_s_sleep(1); \
    if ((++_sp & 255u) == 0u) { if (xb_ld(&(bar)[XB_TMO])) break; if (_sp > XB_SPIN_CAP) { atomicAdd(&(bar)[XB_TMO], 1u); break; } } } } while (0)

struct XcdBarrier {
    unsigned* bar; unsigned x;
    volatile LAS unsigned* st;
};

__device__ __forceinline__ XcdBarrier xcd_barrier_post(unsigned* bar, volatile LAS unsigned* st) {
    XcdBarrier b; b.bar = bar; b.x = xb_xcc_id(); b.st = st;
    if (threadIdx.x == 0) (void)xb_add(&bar[XB_XCNT(b.x)], 1u);
    return b;
}
__device__ __forceinline__ void xcd_barrier_complete(unsigned* bar, unsigned x, unsigned& nloc, unsigned& nx) {
    const unsigned G = gridDim.x * gridDim.y * gridDim.z;
    unsigned sum, cnt, mine, sp = 0u;
    for (;;) {
        sum = 0u; cnt = 0u; mine = 0u;
#pragma unroll
        for (unsigned j = 0; j < 16; ++j) { const unsigned c = xb_ld(&bar[XB_XCNT(j)]); sum += c; cnt += (c > 0u) ? 1u : 0u; mine = (j == x) ? c : mine; }
        if (sum == G) break;
        __builtin_amdgcn_s_sleep(1);
        if ((++sp & 255u) == 0u) { if (xb_ld(&bar[XB_TMO])) break; if (sp > XB_SPIN_CAP) { atomicAdd(&bar[XB_TMO], 1u); break; } }
    }
    nloc = mine > 0u ? mine : 1u; nx = cnt > 0u ? cnt : 1u;
}

__device__ __forceinline__ void xcd_barrier(const XcdBarrier& b) {
    asm volatile("s_waitcnt vmcnt(0)" ::: "memory");
    __syncthreads();
    if (threadIdx.x == 0) {
        unsigned* bar = b.bar;
        __builtin_amdgcn_s_waitcnt(0);
        unsigned nloc = b.st[0], nx = b.st[1];
        if (nloc == 0u) { xcd_barrier_complete(bar, b.x, nloc, nx); b.st[0] = nloc; b.st[1] = nx; }
        const unsigned old = xb_add(&bar[XB_XSUB(b.x)], 1u);
        const unsigned gen = old / nloc;
        if (old + 1u == (gen + 1u) * nloc) {
            __builtin_amdgcn_fence(__ATOMIC_RELEASE, "agent");
            asm volatile("s_waitcnt vmcnt(0)" ::: "memory");
            const unsigned og = xb_add(&bar[XB_TOP], 1u);
            const unsigned tg = og / nx;
            if (og + 1u == (tg + 1u) * nx) xb_add(&bar[XB_TOPGEN], 1u);
            else XB_SPIN(xb_ld(&bar[XB_TOPGEN]) == tg, bar);
            __builtin_amdgcn_fence(__ATOMIC_ACQUIRE, "agent");
            xb_add(&bar[XB_XGEN(b.x)], 1u);
            asm volatile("s_waitcnt vmcnt(0)" ::: "memory");
        } else {
            XB_SPIN(xb_ld(&bar[XB_XGEN(b.x)]) == gen, bar);
            __builtin_amdgcn_fence(__ATOMIC_ACQUIRE, "agent");
            asm volatile("s_waitcnt vmcnt(0)" ::: "memory");
        }
    }
    __syncthreads();
}


__global__ void __launch_bounds__(512) fwd_megakernel(Args args) {
    extern __shared__ __attribute__((aligned(16))) unsigned char lds_raw[];
    cg::grid_group grid = cg::this_grid();
    Fr B0;
    B0.lds = (LAS unsigned char*)lds_raw; B0.tid = 0; B0.lane = 0; B0.wave = __builtin_amdgcn_readfirstlane(threadIdx.x >> 6); B0.G = gridDim.x; B0.bx = blockIdx.x;
    const CAS unsigned char* kargp = (const CAS unsigned char*)__builtin_amdgcn_kernarg_segment_ptr();
    if (threadIdx.x < 16) ((LAS unsigned*)(B0.lds + LDS_MISC))[threadIdx.x] = 0u;
    __syncthreads();
    const XcdBarrier bar = xcd_barrier_post((unsigned*)(args.ws + WS_BAR), (volatile LAS unsigned*)(B0.lds + LDS_MISC));
    const int lo = args.ph_lo, hi = args.ph_hi;
    if (hi < 0) grid.sync();
    int ph = 0;
#define PH_BEGIN_G(g) if (ph >= lo && ph < hi) for (int rep_ = 0; rep_ < (int)((DUP_MASK >> (g)) & 1) + 1; ++rep_) { Fr F = B0; { unsigned m1_ = ~0u; asm volatile("" : "+s"(m1_)); F.lane = (int)__builtin_amdgcn_mbcnt_hi(m1_, __builtin_amdgcn_mbcnt_lo(m1_, 0u)); } asm volatile("" : "+s"(F.G)); asm volatile("" : "+s"(F.bx)); asm volatile("" : "+s"(F.wave)); F.tid = F.wave * 64 + F.lane; fill_ptrs(F, kargp);
#define PH_END xcd_barrier(bar); } ++ph;

    PH_BEGIN_G(0)
#ifndef NO_PRO
 ph_prologue(F);
#endif
 PH_END

#pragma unroll 1
    for (int layer = 0; layer < DEPTH; ++layer) {
        const int mix = layer % 3, j = layer / 3; const bool last = (layer == DEPTH - 1);
        PH_BEGIN_G(1) ph_norm(F, layer, 0, MT, layer == 0 ? 0 : DFF / 256); PH_END
        PH_BEGIN_G(2) { EpiSwiglu E{F.H}; run_gemm(F, F.XN, F.WFI + (size_t)(layer * 2 + 0) * 2 * DFF * D, MT, 2 * DFF, D, E); } PH_END
        PH_BEGIN_G(3) run_resid_gemm(F, F.H, F.WFO + (size_t)(layer * 2 + 0) * D * DFF, DFF, true, F.MOD + (size_t)layer * 2 * NMODV, 2, rep_ == (int)((DUP_MASK >> 3) & 1) ? 0.5f : 0.0f); PH_END
        PH_BEGIN_G(1) ph_norm(F, layer, 1, MT, DFF / 256); PH_END
        const int Mact = last ? SEQ : MT;
        if (mix == 0) {
            PH_BEGIN_G(4) { EpiGlaIn E{F.P, F.LR}; run_gemm(F, F.XN, F.WGI + (size_t)j * GLA_NP * D, MT, GLA_NP, D, E); } PH_END
            PH_BEGIN_G(6)
#ifndef NO_GLAB
 for (int u = F.bx; u < NCH * 8; u += F.G) gla_b_unit(F, j, u >> 3, (u >> 1) & 3, u & 1);
#endif
 PH_END
            PH_BEGIN_G(31)
#ifndef NO_GLAC
 gla_scan(F);
#endif
 PH_END
            PH_BEGIN_G(7)
#ifndef NO_GLAD
 { const int nu = (last ? 256 : NCH) * 4; for (int u = F.bx; u < nu; u += F.G) gla_d_unit(F, j, u >> 2, u & 3); }
#endif
 PH_END
            PH_BEGIN_G(5) run_resid_gemm(F, F.OB, F.WGO + (size_t)j * D * D, D, !last, F.MOD + (size_t)layer * 2 * NMODV, 5, rep_ == (int)((DUP_MASK >> 5) & 1) ? 1.0f : 0.0f); PH_END
        } else if (mix == 1) {
            PH_BEGIN_G(4) { EpiRgIn E{F.GG, F.XR}; run_gemm(F, F.XN, F.WRI, MT, 3072, D, E); } PH_END
            PH_BEGIN_G(8)
#ifndef NO_RG
 { int it_ = 0; for (int u = F.bx; u < NCH * 12; u += F.G, ++it_) rg_unit(F, u / 12, u % 12, 0, it_ & 1); __syncthreads(); }
#endif
 PH_END
            PH_BEGIN_G(9) rg_carry(F); PH_END
            PH_BEGIN_G(11)
#ifndef NO_RG
 for (int u = F.bx; u < NCH * 12; u += F.G) rg_unit1(F, u / 12, u % 12);
#endif
 PH_END
            PH_BEGIN_G(5) run_resid_gemm(F, F.OB, F.WRO, 1536, !last, F.MOD + (size_t)layer * 2 * NMODV, 5, rep_ == (int)((DUP_MASK >> 5) & 1) ? 1.0f : 0.0f); PH_END
        } else {
            PH_BEGIN_G(4) { EpiSwaQkv E{F.QKV, F.ROPE}; run_gemm(F, F.XN, F.WSQ, MT, 1536, D, E); } PH_END
            PH_BEGIN_G(10)
#ifndef NO_SWA
 for (int u = F.bx; u < NCH * 4; u += F.G) swa_unit(F, u >> 2, u & 3);
#endif
 PH_END
            PH_BEGIN_G(5) run_resid_gemm(F, F.OB, F.WSO, D, !last, F.MOD + (size_t)layer * 2 * NMODV, 5, rep_ == (int)((DUP_MASK >> 5) & 1) ? 1.0f : 0.0f); PH_END
        }
        PH_BEGIN_G(1) ph_norm(F, layer, 2, Mact, mix == 1 ? 1536 / 256 : D / 256); PH_END
        PH_BEGIN_G(2) { EpiSwiglu E{F.H}; run_gemm(F, F.XN, F.WFI + (size_t)(layer * 2 + 1) * 2 * DFF * D, Mact, 2 * DFF, D, E); } PH_END
        PH_BEGIN_G(3) run_resid_gemm(F, F.H, F.WFO + (size_t)(layer * 2 + 1) * D * DFF, DFF, !last, F.MOD + (size_t)layer * 2 * NMODV, 8, rep_ == (int)((DUP_MASK >> 3) & 1) ? 0.5f : 0.0f); PH_END
    }
#ifdef DBG_CHECK
    { Fr F = B0; { unsigned m1_ = ~0u; asm volatile("" : "+s"(m1_)); F.lane = (int)__builtin_amdgcn_mbcnt_hi(m1_, __builtin_amdgcn_mbcnt_lo(m1_, 0u)); } asm volatile("" : "+s"(F.G)); asm volatile("" : "+s"(F.bx)); asm volatile("" : "+s"(F.wave)); F.tid = F.wave * 64 + F.lane; fill_ptrs(F, kargp);
      unsigned* flag = (unsigned*)(F.ws + 512 * 1024);
      dbg_scan(F, flag);
      for (size_t i = (size_t)F.bx * 512 + F.tid; i < (size_t)SEQ * D; i += (size_t)F.G * 512) F.out[i] = 0.f;
      xcd_barrier(bar);
      if (F.bx == 0 && F.tid == 0) F.out[0] = 1000.0f * (float)(__hip_atomic_load(flag, __ATOMIC_RELAXED, __HIP_MEMORY_SCOPE_AGENT) + 1u);
    }
#else
    { Fr F = B0; { unsigned m1_ = ~0u; asm volatile("" : "+s"(m1_)); F.lane = (int)__builtin_amdgcn_mbcnt_hi(m1_, __builtin_amdgcn_mbcnt_lo(m1_, 0u)); } asm volatile("" : "+s"(F.G)); asm volatile("" : "+s"(F.bx)); asm volatile("" : "+s"(F.wave)); F.tid = F.wave * 64 + F.lane; fill_ptrs(F, kargp); ph_final(F); }
#endif
}

extern "C" void kernel_launch(void* const* d_in, const int* in_sizes, int n_in, void* d_out, int out_size, void* d_ws, size_t ws_size, hipStream_t stream) {
    static int grid = 0;
    if (grid == 0) {
        if (n_in != 27 || out_size != SEQ * D || ws_size < WS_END) { fprintf(stderr, "kernel_launch: unexpected shapes (n_in %d out %d ws %zu)\n", n_in, out_size, ws_size); grid = -1; return; }
        int dev = 0, cus = 0, per_cu = 0;
        hipGetDevice(&dev);
        hipDeviceGetAttribute(&cus, hipDeviceAttributeMultiprocessorCount, dev);
        hipFuncSetAttribute((const void*)fwd_megakernel, hipFuncAttributeMaxDynamicSharedMemorySize, LDS_BYTES);
        hipOccupancyMaxActiveBlocksPerMultiprocessor(&per_cu, (const void*)fwd_megakernel, 512, LDS_BYTES);
        if (per_cu < 1) { fprintf(stderr, "kernel_launch: occupancy query says %d blocks per CU\n", per_cu); per_cu = 1; }
        (void)hipGetLastError();
        grid = cus * 1;
        fprintf(stderr, "kernel_launch: grid %d (cus %d, per_cu %d)\n", grid, cus, per_cu);
    }
    if (grid < 0) return;
    if (hipMemsetAsync((char*)d_ws + WS_BAR, 0, BAR_BYTES, stream) != hipSuccess) { fprintf(stderr, "kernel_launch: memset failed\n"); return; }
    Args a{};
    for (int i = 0; i < 27; ++i) a.in[i] = (const float*)d_in[i];
    a.out = (float*)d_out; a.ws = (unsigned char*)d_ws; a.ph_lo = 0; a.ph_hi = PH_LIMIT;
    void* kargs[] = {&a};
    hipError_t e = hipLaunchCooperativeKernel((const void*)fwd_megakernel, dim3(grid), dim3(512), kargs, LDS_BYTES, stream);
    if (e != hipSuccess) fprintf(stderr, "cooperative launch failed: %s (grid %d)\n", hipGetErrorString(e), grid);
}
```

```cpp
#include <hip/hip_runtime.h>
#include <hip/hip_cooperative_groups.h>
#include <cstdio>
#include <cstdint>
namespace cg = cooperative_groups;
namespace pg8 {
#define PG8_LAS __attribute__((address_space(3)))
typedef unsigned short bf16_t;
typedef short bf16x8 __attribute__((ext_vector_type(8)));
typedef float f32x4 __attribute__((ext_vector_type(4)));
typedef unsigned u32x4 __attribute__((ext_vector_type(4)));
constexpr int BM = 256, BK = 64, HALF = 128, HTB = HALF * BK * 2  , STAGE_BYTES = 8 * HTB, NXCD = 8, WGM = 8;

__host__ __device__ __forceinline__ int lds_byte(int r, int c) { const int st = (r >> 4) * 2 + (c >> 5), rr = r & 15, cc = c & 31, ob = rr * 64 + cc * 2; return st * 1024 + (ob ^ (((ob >> 9) & 1) << 5)); }
__host__ __device__ __forceinline__ void stage_rc(int b, int& R, int& C) { const int st = b / 1024, sb = b % 1024, swz = sb ^ (((sb >> 9) & 1) << 5); R = (st >> 1) * 16 + swz / 64; C = (st & 1) * 32 + (swz % 64) / 2; }
__host__ __device__ __forceinline__ int perm32(int rho) { const int n = rho >> 4, i = rho & 15; return 8 * (i >> 2) + 4 * n + (i & 3); }

struct Unit { int pm, pn, ks; };
struct Gemm { const bf16_t* A; const bf16_t* Bt; int M, N, K, KS; };

struct StaticOrder {
    int nM, nN, nwg, G, c;
    __host__ __device__ void init(int M, int N, int G_, int c_) { nM = M / BM; nN = N / BM; nwg = nM * nN; G = G_; c = c_; }
    __host__ __device__ bool next(int i, Unit& u) const {
        const long L = (long)i * G + c; if (L >= nwg) return false;
        int wgid = (int)L; { const int q = nwg / NXCD, r = nwg % NXCD, xcd = wgid % NXCD, off = wgid / NXCD; wgid = (xcd < r ? xcd * (q + 1) : r * (q + 1) + (xcd - r) * q) + off; }
        const int nig = WGM * nN, gid = wgid / nig, fm = gid * WGM, gsz = (nM - fm) < WGM ? (nM - fm) : WGM;
        u.pm = fm + ((wgid % nig) % gsz); u.pn = (wgid % nig) / gsz; u.ks = 0; return true;
    }
    __device__ __forceinline__ void a_ready(const Unit&) const {}
    __device__ __forceinline__ void done(const Unit&) const {}
};
struct SplitKOrder {
    int pm, nN, nks, G, c;
    __host__ __device__ bool next(int i, Unit& u) const { const int L = i * G + c; if (L >= nN * nks) return false; u.pm = pm; u.pn = L % nN; u.ks = L / nN; return true; }
    __device__ __forceinline__ void a_ready(const Unit&) const {}
    __device__ __forceinline__ void done(const Unit&) const {}
};
__device__ __forceinline__ unsigned cvt_pk_bf16(float lo, float hi) { unsigned r; asm volatile("v_cvt_pk_bf16_f32 %0, %1, %2" : "=v"(r) : "v"(lo), "v"(hi)); return r; }
template <class Epi, class Sched, bool ALIGN_EPI = false, bool SP2 = false>
__device__ __forceinline__ void gemm_phase(PG8_LAS unsigned char* lds, const Gemm g, const Sched& S, const Epi& E, const int tid_in) {
    const int tid = tid_in, wid = __builtin_amdgcn_readfirstlane(tid >> 6), lane = tid & 63, wr = wid >> 2, wc = wid & 3, fr = lane & 15, fq = lane >> 4;
    const int K = g.K, nt = g.KS / BK; const size_t ksb = (size_t)g.KS * 2;
    unsigned voffA[2], voffB[2];
#pragma unroll
    for (int i = 0; i < 2; ++i) { int R, C; stage_rc(tid * 16 + i * 8192, R, C); const int Rb = Epi::PERM ? ((R & ~31) + perm32(R & 31)) : R;
        voffA[i] = (unsigned)(R * K + C) * 2u; voffB[i] = (unsigned)(Rb * K + C) * 2u; }
    const size_t kstep = (size_t)(BK * 2);
    const size_t hstep = (size_t)HALF * K * 2;
    const size_t tstep = 2 * hstep;
    const unsigned ldsw = (unsigned)wid * 1024u;
    const int aoff = lds_byte(wr * 64 + fr, fq * 8), boff = lds_byte(wc * 32 + fr, fq * 8);
#define PG8_SA(b, h) (((b) * 2 + (h)) * HTB)
#define PG8_SB(b, h) ((4 + (b) * 2 + (h)) * HTB)
#define PG8_STAGE(bufoff, gbase, voff) do { _Pragma("unroll") for (int _i = 0; _i < 2; ++_i) \
        __builtin_amdgcn_global_load_lds((const unsigned*)((const char*)(gbase) + (voff)[_i]), (PG8_LAS unsigned*)(lds + (bufoff) + ldsw + _i * 8192), 16, 0, 0); } while (0)
#define PG8_LDA(dst, b, h) do { _Pragma("unroll") for (int m = 0; m < 4; ++m) _Pragma("unroll") for (int k = 0; k < 2; ++k) dst[m][k] = *(const PG8_LAS bf16x8*)(lds + PG8_SA(b, h) + aoff + m * 2048 + k * 1024); } while (0)
#define PG8_LDB(dst, b, h) do { _Pragma("unroll") for (int n = 0; n < 2; ++n) _Pragma("unroll") for (int k = 0; k < 2; ++k) dst[n][k] = *(const PG8_LAS bf16x8*)(lds + PG8_SB(b, h) + boff + n * 2048 + k * 1024); } while (0)
#define PG8_MMA(ai, bj, At, Bt) do { __builtin_amdgcn_s_setprio(1); _Pragma("unroll") for (int m = 0; m < 4; ++m) _Pragma("unroll") for (int n = 0; n < 2; ++n) _Pragma("unroll") for (int k = 0; k < 2; ++k) \
        acc[ai][bj][m][n] = __builtin_amdgcn_mfma_f32_16x16x32_bf16(Bt[n][k], At[m][k], acc[ai][bj][m][n], 0, 0, 0); __builtin_amdgcn_s_setprio(0); } while (0)
#define PG8_WAIT_V(n) asm volatile("s_waitcnt vmcnt(" #n ")" ::: "memory")
#define PG8_WAIT_L(n) asm volatile("s_waitcnt lgkmcnt(" #n ")" ::: "memory")
#define PG8_BAR __builtin_amdgcn_s_barrier()
#define PG8_SCHED __builtin_amdgcn_sched_barrier(0)
    Unit cur, nxt; int ui = 0;
    if (!S.next(0, cur)) return;
    f32x4 acc[2][2][4][2];
#pragma unroll
    for (int a = 0; a < 2; ++a)
#pragma unroll
        for (int b = 0; b < 2; ++b)
#pragma unroll
            for (int m = 0; m < 4; ++m)
#pragma unroll
                for (int n = 0; n < 2; ++n) acc[a][b][m][n] = (f32x4){0.f, 0.f, 0.f, 0.f};
    bf16x8 At[4][2], B0[2][2], B1[2][2];
    const char* cA = (const char*)g.A + (size_t)cur.pm * tstep + (size_t)cur.ks * ksb; const char* cB = (const char*)g.Bt + (size_t)cur.pn * tstep + (size_t)cur.ks * ksb;
    S.a_ready(cur);
    if constexpr (SP2) {
        PG8_STAGE(PG8_SB(0, 0), cB, voffB); PG8_STAGE(PG8_SB(0, 1), cB + hstep, voffB); PG8_STAGE(PG8_SA(0, 0), cA, voffA); PG8_STAGE(PG8_SA(0, 1), cA + hstep, voffA);
        if (wr == 1) PG8_BAR;
        PG8_WAIT_V(2); PG8_BAR;
        PG8_STAGE(PG8_SB(1, 0), cB + kstep, voffB); PG8_STAGE(PG8_SA(1, 0), cA + kstep, voffA); PG8_STAGE(PG8_SB(1, 1), cB + hstep + kstep, voffB);
        PG8_WAIT_V(6); PG8_BAR;
    } else {
        PG8_STAGE(PG8_SB(0, 0), cB, voffB); PG8_STAGE(PG8_SA(0, 0), cA, voffA); PG8_STAGE(PG8_SB(0, 1), cB + hstep, voffB); PG8_STAGE(PG8_SA(0, 1), cA + hstep, voffA);
        if (wr == 1) PG8_BAR;
        PG8_WAIT_V(4); PG8_BAR;
        PG8_STAGE(PG8_SB(1, 0), cB + kstep, voffB); PG8_STAGE(PG8_SA(1, 0), cA + kstep, voffA); PG8_STAGE(PG8_SB(1, 1), cB + hstep + kstep, voffB);
        PG8_WAIT_V(6); PG8_BAR;
    }
    for (;;) {
        const bool has_next = S.next(ui + 1, nxt);
        const char* nA = has_next ? (const char*)g.A + (size_t)nxt.pm * tstep + (size_t)nxt.ks * ksb : cA; const char* nB = has_next ? (const char*)g.Bt + (size_t)nxt.pn * tstep + (size_t)nxt.ks * ksb : cB;
        for (int t = 0; t < nt; t += 2) {
            const bool last = (t == nt - 2);
            const char* a1 = cA + (size_t)(t + 1) * kstep;
            const char* a2 = last ? nA : cA + (size_t)(t + 2) * kstep; const char* b2 = last ? nB : cB + (size_t)(t + 2) * kstep;
            const char* a3 = a2 + kstep; const char* b3 = b2 + kstep;
            if (last && has_next) S.a_ready(nxt);
            if constexpr (SP2) {
            PG8_LDB(B0, 0, 0); PG8_LDB(B1, 0, 1); PG8_SCHED; PG8_LDA(At, 0, 0); PG8_STAGE(PG8_SA(1, 1), a1 + hstep, voffA);
            PG8_WAIT_V(8); PG8_WAIT_L(0); PG8_BAR; PG8_MMA(0, 0, At, B0); PG8_MMA(0, 1, At, B1); PG8_BAR; PG8_SCHED;
            PG8_LDA(At, 0, 1); PG8_STAGE(PG8_SB(0, 0), b2, voffB); PG8_STAGE(PG8_SB(0, 1), b2 + hstep, voffB); PG8_STAGE(PG8_SA(0, 0), a2, voffA);
            PG8_WAIT_V(8); PG8_WAIT_L(0); PG8_BAR; PG8_MMA(1, 0, At, B0); PG8_MMA(1, 1, At, B1); PG8_BAR; PG8_SCHED;
            PG8_LDB(B0, 1, 0); PG8_LDB(B1, 1, 1); PG8_SCHED; PG8_LDA(At, 1, 0); PG8_STAGE(PG8_SA(0, 1), a2 + hstep, voffA);
            PG8_WAIT_V(8); PG8_WAIT_L(0); PG8_BAR; PG8_MMA(0, 0, At, B0); PG8_MMA(0, 1, At, B1); PG8_BAR; PG8_SCHED;
            PG8_LDA(At, 1, 1); PG8_STAGE(PG8_SB(1, 0), b3, voffB); PG8_STAGE(PG8_SB(1, 1), b3 + hstep, voffB); PG8_STAGE(PG8_SA(1, 0), a3, voffA);
            PG8_WAIT_V(8); PG8_WAIT_L(0); PG8_BAR; PG8_MMA(1, 0, At, B0); PG8_MMA(1, 1, At, B1); PG8_BAR; PG8_SCHED;
            } else {
            PG8_LDB(B0, 0, 0); PG8_SCHED; PG8_LDA(At, 0, 0); PG8_STAGE(PG8_SA(1, 1), a1 + hstep, voffA);
            PG8_WAIT_L(8); PG8_BAR; PG8_WAIT_L(0); PG8_MMA(0, 0, At, B0); PG8_BAR; PG8_SCHED;
            PG8_LDB(B1, 0, 1); PG8_STAGE(PG8_SB(0, 0), b2, voffB);
            PG8_BAR; PG8_WAIT_L(0); PG8_MMA(0, 1, At, B1); PG8_BAR;
            PG8_LDA(At, 0, 1); PG8_STAGE(PG8_SA(0, 0), a2, voffA);
            PG8_BAR; PG8_WAIT_L(0); PG8_MMA(1, 0, At, B0); PG8_BAR; PG8_SCHED;
            PG8_STAGE(PG8_SB(0, 1), b2 + hstep, voffB);
            PG8_WAIT_V(6); PG8_BAR; PG8_MMA(1, 1, At, B1); PG8_BAR;
            PG8_LDB(B0, 1, 0); PG8_SCHED; PG8_LDA(At, 1, 0); PG8_STAGE(PG8_SA(0, 1), a2 + hstep, voffA);
            PG8_WAIT_L(8); PG8_BAR; PG8_WAIT_L(0); PG8_MMA(0, 0, At, B0); PG8_BAR; PG8_SCHED;
            PG8_LDB(B1, 1, 1); PG8_STAGE(PG8_SB(1, 0), b3, voffB);
            PG8_BAR; PG8_WAIT_L(0); PG8_MMA(0, 1, At, B1); PG8_BAR;
            PG8_LDA(At, 1, 1); PG8_STAGE(PG8_SA(1, 0), a3, voffA);
            PG8_BAR; PG8_WAIT_L(0); PG8_MMA(1, 0, At, B0); PG8_BAR; PG8_SCHED;
            PG8_STAGE(PG8_SB(1, 1), b3 + hstep, voffB);
            PG8_WAIT_V(6); PG8_BAR; PG8_MMA(1, 1, At, B1); PG8_BAR;
            }
        }
        if constexpr (ALIGN_EPI) { if (wr == 0) PG8_BAR; }
        if constexpr (!Epi::AFTER_DRAIN) { E(acc, cur, wr, wc, fr, fq); S.done(cur); }
        if (!has_next) break;
#pragma unroll
        for (int a = 0; a < 2; ++a)
#pragma unroll
            for (int b = 0; b < 2; ++b)
#pragma unroll
                for (int m = 0; m < 4; ++m)
#pragma unroll
                    for (int n = 0; n < 2; ++n) acc[a][b][m][n] = (f32x4){0.f, 0.f, 0.f, 0.f};
        cur = nxt; cA = nA; cB = nB; ++ui;
        if constexpr (ALIGN_EPI) { if (wr == 1) PG8_BAR; }
    }
    PG8_WAIT_V(0);
    if constexpr (!ALIGN_EPI) { if (wr == 0) PG8_BAR; }
    PG8_BAR;
    if constexpr (Epi::AFTER_DRAIN) { E.fused(acc, cur, wr, wc, fr, fq, lds, wid, lane); S.done(cur); }
#undef PG8_SA
#undef PG8_SB
#undef PG8_STAGE
#undef PG8_LDA
#undef PG8_LDB
#undef PG8_MMA
#undef PG8_WAIT_V
#undef PG8_WAIT_L
#undef PG8_BAR
#undef PG8_SCHED
}
}

#define LAS __attribute__((address_space(3)))
typedef unsigned short bf16;
typedef short bf16x8 __attribute__((ext_vector_type(8)));
typedef short bf16x4 __attribute__((ext_vector_type(4)));
typedef float f32x4 __attribute__((ext_vector_type(4)));
typedef float f32x2 __attribute__((ext_vector_type(2)));
typedef unsigned u32x4 __attribute__((ext_vector_type(4)));
typedef unsigned u32x2 __attribute__((ext_vector_type(2)));

constexpr int D = 1024, SEQ = 16384, CTXL = 256, MT = SEQ + CTXL, DFF = 2816, NMODV = 9 * 1024, DEPTH = 4;
constexpr int NCH = MT / 64;
constexpr int GLA_NP = 3328;
constexpr float NORM_EPS = 1e-6f;
constexpr size_t MiB = 1u << 20;
constexpr size_t WS_MOD = 0, WS_ROPE = 1 * MiB, WS_WFI = 2 * MiB, WS_WFO = 90 * MiB, WS_WGI = 134 * MiB, WS_WGO = 147 * MiB, WS_WRI = 151 * MiB, WS_WRO = 157 * MiB,
                 WS_WRA = 160 * MiB, WS_WRX = 161 * MiB, WS_WSQ = 162 * MiB, WS_WSO = 165 * MiB, WS_X = 168 * MiB, WS_XN = 233 * MiB, WS_OB = 266 * MiB, WS_AR = 315 * MiB, WS_SLAB = 622 * MiB, WS_END = 634 * MiB;
constexpr size_t A_H = 0;
constexpr size_t A_P = 0, A_LR = 98 * MiB, A_QD = 101 * MiB, A_KN = 134 * MiB, A_DEC = 167 * MiB, A_US = 169 * MiB;
constexpr size_t A_GG = 0, A_XR = 49 * MiB, A_AP = 98 * MiB, A_HE = 102 * MiB, A_CIN = 106 * MiB, A_LA = 110 * MiB, A_UU = 208 * MiB;
constexpr size_t A_QKV = 0;
#ifndef DUP_MASK
#define DUP_MASK 0
#endif
constexpr int LDS_BYTES = 135168;
constexpr int LDS_MISC = 135168 - 64;
constexpr size_t WS_BAR = 640 * 1024, BAR_BYTES = 16384;
#ifndef PH_LIMIT
#define PH_LIMIT (1 << 20)
#endif

struct Args { const float* in[27]; float* out; unsigned char* ws; int ph_lo, ph_hi; };

struct Fr {
    LAS unsigned char* lds; int tid, lane, wave, G, bx;
    const float *x, *c, *ctx, *c_ctx, *ada_w, *ada_b, *norm_g, *final_g, *ffn_w_in, *ffn_w_out, *gla_w_in, *gla_w_a2, *gla_b_a, *gla_norm_g, *gla_w_out,
        *rg_w_in, *rg_conv_w, *rg_conv_b, *rg_w_a, *rg_b_a, *rg_w_x, *rg_b_x, *rg_lam, *rg_w_out, *swa_w_qkv, *swa_sink, *swa_w_out;
    float* out; unsigned char* ws;
    float *MOD, *ROPE, *X; bf16 *WFI, *WFO, *WGI, *WGO, *WRI, *WRO, *WRA, *WRX, *WSQ, *WSO, *XN, *OB, *H;
    bf16 *P, *QD, *KN, *US; float *LR, *DEC;
    bf16 *GG, *XR, *LAg, *UUg; float *AP, *HE, *CIN;
    bf16* QKV; float* SLAB;
};

typedef __bf16 bf16x2_t __attribute__((ext_vector_type(2)));
__device__ __forceinline__ unsigned pk2(float lo, float hi) { f32x2 v = {lo, hi}; bf16x2_t b = __builtin_convertvector(v, bf16x2_t); return __builtin_bit_cast(unsigned, b); }
__device__ __forceinline__ float bf2f(unsigned short b) { return __uint_as_float(((unsigned)b) << 16); }
__device__ __forceinline__ float bflo(unsigned u) { return __uint_as_float(u << 16); }
__device__ __forceinline__ float bfhi(unsigned u) { return __uint_as_float(u & 0xffff0000u); }
__device__ __forceinline__ unsigned short f2bf1(float f) { return (unsigned short)(pk2(f, 0.f) & 0xffffu); }
__device__ __forceinline__ float shx(float v, int o, int lane) { return __builtin_bit_cast(float, __builtin_amdgcn_ds_bpermute((lane ^ o) << 2, __builtin_bit_cast(int, v))); }
__device__ __forceinline__ float wave_sum(float v, int lane) {
#pragma unroll
    for (int o = 1; o < 64; o <<= 1) v += shx(v, o, lane);
    return v;
}
__device__ __forceinline__ f32x4 mma(bf16x8 a, bf16x8 b, f32x4 c) { return __builtin_amdgcn_mfma_f32_16x16x32_bf16(a, b, c, 0, 0, 0); }
__device__ __forceinline__ float sigmoidf_(float x) { return __builtin_amdgcn_rcpf(1.0f + __expf(-x)); }
__device__ __forceinline__ float siluf_(float x) { return x * sigmoidf_(x); }
__device__ __forceinline__ float gelu_tanh_(float x) { const float y = 0.7978845608028654f * (x + 0.044715f * x * x * x); return x * sigmoidf_(2.0f * y); }
__device__ __forceinline__ float logsigmoid_(float x) { return fminf(x, 0.f) - __logf(1.0f + __expf(-fabsf(x))); }
__device__ __forceinline__ float softplus_(float x) { return fmaxf(x, 0.f) + __logf(1.0f + __expf(-fabsf(x))); }
#define LDS_WAIT() asm volatile("s_waitcnt lgkmcnt(0)" ::: "memory")

using pg8::Unit;
struct EpiSwiglu {
    static constexpr bool PERM = true, AFTER_DRAIN = false;
    bf16* H;
    __device__ __forceinline__ void operator()(const f32x4 (&acc)[2][2][4][2], const Unit& u, int wr, int wc, int fr, int fq) const {
        int z0 = 0; asm volatile("" : "+v"(z0));
        const int row0 = u.pm * 256 + wr * 64 + fr + z0, col0 = u.pn * 128 + wc * 32 + 8 * fq;
#pragma unroll
        for (int ai = 0; ai < 2; ++ai)
#pragma unroll
            for (int m = 0; m < 4; ++m) {
                bf16* rowp = H + (size_t)(row0 + ai * 128 + m * 16) * DFF + col0;
                const f32x4 g0 = acc[ai][0][m][0], g1 = acc[ai][0][m][1], u0 = acc[ai][1][m][0], u1 = acc[ai][1][m][1];
                u32x4 w;
                w.x = pk2(siluf_(g0[0]) * u0[0], siluf_(g0[1]) * u0[1]); w.y = pk2(siluf_(g0[2]) * u0[2], siluf_(g0[3]) * u0[3]);
                w.z = pk2(siluf_(g1[0]) * u1[0], siluf_(g1[1]) * u1[1]); w.w = pk2(siluf_(g1[2]) * u1[2], siluf_(g1[3]) * u1[3]);
                *(u32x4*)rowp = w;
            }
    }
};
struct EpiResid {
    static constexpr bool PERM = false, AFTER_DRAIN = false;
    float* X; const float* modl; int gidx; float coef;
    __device__ __forceinline__ void operator()(const f32x4 (&acc)[2][2][4][2], const Unit& u, int wr, int wc, int fr, int fq) const {
        const float* gp = modl + (u.pm == 64 ? NMODV : 0) + gidx * 1024;
        int z0 = 0; asm volatile("" : "+v"(z0));
        const int row0 = u.pm * 256 + wr * 64 + fr + z0, col0 = u.pn * 256 + wc * 32 + 4 * fq;
#pragma unroll
        for (int bj = 0; bj < 2; ++bj)
#pragma unroll
            for (int n = 0; n < 2; ++n) {
                const int col = col0 + bj * 128 + n * 16;
                const f32x4 gv = *(const f32x4*)(gp + col) * coef;
#pragma unroll
                for (int ai = 0; ai < 2; ++ai)
#pragma unroll
                    for (int m = 0; m < 4; ++m) {
                        float* p = X + (size_t)(row0 + ai * 128 + m * 16) * D + col;
                        f32x4 v = *(const f32x4*)p; v += gv * acc[ai][bj][m][n]; *(f32x4*)p = v;
                    }
            }
    }
};
struct EpiGlaIn {
    static constexpr bool PERM = true, AFTER_DRAIN = false;
    bf16* P; float* LR;
    __device__ __forceinline__ void operator()(const f32x4 (&acc)[2][2][4][2], const Unit& u, int wr, int wc, int fr, int fq) const {
        int z0 = 0; asm volatile("" : "+v"(z0));
        const int row0 = u.pm * 256 + wr * 64 + fr + z0;
        if (u.pn < 12) {
            const float sc = (u.pn < 2) ? 0.08838834764831845f : 1.0f;
            const int col0 = u.pn * 256 + wc * 32 + 8 * fq;
#pragma unroll
            for (int ai = 0; ai < 2; ++ai)
#pragma unroll
                for (int m = 0; m < 4; ++m)
#pragma unroll
                    for (int bj = 0; bj < 2; ++bj) {
                        const f32x4 v0 = acc[ai][bj][m][0] * sc, v1 = acc[ai][bj][m][1] * sc;
                        u32x4 w; w.x = pk2(v0[0], v0[1]); w.y = pk2(v0[2], v0[3]); w.z = pk2(v1[0], v1[1]); w.w = pk2(v1[2], v1[3]);
                        *(u32x4*)(P + (size_t)(row0 + ai * 128 + m * 16) * 3072 + col0 + bj * 128) = w;
                    }
        } else if (wc == 0) {
#pragma unroll
            for (int ai = 0; ai < 2; ++ai)
#pragma unroll
                for (int m = 0; m < 4; ++m) {
                    float* p = LR + (size_t)(row0 + ai * 128 + m * 16) * 32 + 8 * fq;
                    *(f32x4*)p = acc[ai][0][m][0]; *(f32x4*)(p + 4) = acc[ai][0][m][1];
                }
        }
    }
};
struct EpiRgIn {
    static constexpr bool PERM = true, AFTER_DRAIN = false;
    bf16* GG; bf16* XR;
    __device__ __forceinline__ void operator()(const f32x4 (&acc)[2][2][4][2], const Unit& u, int wr, int wc, int fr, int fq) const {
        int z0 = 0; asm volatile("" : "+v"(z0));
        const int row0 = u.pm * 256 + wr * 64 + fr + z0;
        const bool isg = u.pn < 6;
        bf16* base = isg ? GG : XR;
        const int col0 = (isg ? u.pn : u.pn - 6) * 256 + wc * 32 + 8 * fq;
#pragma unroll
        for (int ai = 0; ai < 2; ++ai)
#pragma unroll
            for (int m = 0; m < 4; ++m)
#pragma unroll
                for (int bj = 0; bj < 2; ++bj) {
                    f32x4 v0 = acc[ai][bj][m][0], v1 = acc[ai][bj][m][1];
                    if (isg) {
#pragma unroll
                        for (int e = 0; e < 4; ++e) { v0[e] = gelu_tanh_(v0[e]); v1[e] = gelu_tanh_(v1[e]); }
                    }
                    u32x4 w; w.x = pk2(v0[0], v0[1]); w.y = pk2(v0[2], v0[3]); w.z = pk2(v1[0], v1[1]); w.w = pk2(v1[2], v1[3]);
                    *(u32x4*)(base + (size_t)(row0 + ai * 128 + m * 16) * 1536 + col0 + bj * 128) = w;
                }
    }
};
struct EpiSwaQkv {
    static constexpr bool PERM = false, AFTER_DRAIN = false;
    bf16* QKV; const float* rope;
    __device__ __forceinline__ void operator()(const f32x4 (&acc)[2][2][4][2], const Unit& u, int wr, int wc, int fr, int fq) const {
        int z0 = 0; asm volatile("" : "+v"(z0));
        const int row0 = u.pm * 256 + wr * 64 + fr + z0;
        const float sc = (u.pn < 4) ? 0.125f : 1.0f;
        const bool do_rope = (u.pn < 5) && (u.pm < 64);
        const int col0 = u.pn * 256 + wc * 32 + 4 * fq;
#pragma unroll
        for (int ai = 0; ai < 2; ++ai)
#pragma unroll
            for (int m = 0; m < 4; ++m) {
                const int row = row0 + ai * 128 + m * 16;
                f32x4 cs0 = {1.f, 0.f, 1.f, 0.f}, cs1 = {1.f, 0.f, 1.f, 0.f};
                if (do_rope) { const int id = (wc & 1) ? (row & 63) : (row >> 6); const float* tp = rope + (size_t)(id * 16 + 4 * fq) * 2; cs0 = *(const f32x4*)tp; cs1 = *(const f32x4*)(tp + 4); }
#pragma unroll
                for (int bj = 0; bj < 2; ++bj) {
                    const f32x4 x1 = acc[ai][bj][m][0] * sc, x2 = acc[ai][bj][m][1] * sc;
                    f32x4 o1, o2;
                    o1[0] = x1[0] * cs0[0] - x2[0] * cs0[1]; o2[0] = x2[0] * cs0[0] + x1[0] * cs0[1];
                    o1[1] = x1[1] * cs0[2] - x2[1] * cs0[3]; o2[1] = x2[1] * cs0[2] + x1[1] * cs0[3];
                    o1[2] = x1[2] * cs1[0] - x2[2] * cs1[1]; o2[2] = x2[2] * cs1[0] + x1[2] * cs1[1];
                    o1[3] = x1[3] * cs1[2] - x2[3] * cs1[3]; o2[3] = x2[3] * cs1[2] + x1[3] * cs1[3];
                    bf16* p = QKV + (size_t)row * 1536 + col0 + bj * 128;
                    u32x2 w1, w2; w1.x = pk2(o1[0], o1[1]); w1.y = pk2(o1[2], o1[3]); w2.x = pk2(o2[0], o2[1]); w2.y = pk2(o2[2], o2[3]);
                    *(u32x2*)p = w1; *(u32x2*)(p + 16) = w2;
                }
            }
    }
};

template <class Epi>
__device__ __forceinline__ void run_gemm(const Fr& F, const bf16* A, const bf16* Bt, int M, int N, int K, const Epi& E) {
    pg8::Gemm g{A, Bt, M, N, K, K}; pg8::StaticOrder S; S.init(M, N, F.G, F.bx);
    pg8::gemm_phase<Epi, pg8::StaticOrder, true, true>(F.lds, g, S, E, F.tid);
}


struct EpiSlab {
    static constexpr bool PERM = false, AFTER_DRAIN = false;
    float* SL; const float* modl; int gidx; float coef;
    __device__ __forceinline__ void operator()(const f32x4 (&acc)[2][2][4][2], const Unit& u, int wr, int wc, int fr, int fq) const {
        const float* gp = modl + NMODV + gidx * 1024;
        int z0 = 0; asm volatile("" : "+v"(z0));
        const int row0 = u.ks * 256 + wr * 64 + fr + z0, col0 = u.pn * 256 + wc * 32 + 4 * fq;
#pragma unroll
        for (int bj = 0; bj < 2; ++bj)
#pragma unroll
            for (int n = 0; n < 2; ++n) {
                const int col = col0 + bj * 128 + n * 16;
                const f32x4 gv = *(const f32x4*)(gp + col) * coef;
#pragma unroll
                for (int ai = 0; ai < 2; ++ai)
#pragma unroll
                    for (int m = 0; m < 4; ++m) *(f32x4*)(SL + (size_t)(row0 + ai * 128 + m * 16) * D + col) = gv * acc[ai][bj][m][n];
            }
    }
};
__device__ __forceinline__ void run_resid_gemm(const Fr& F, const bf16* A, const bf16* Bt, int K, bool with_ctx, const float* modl, int gidx, float coef) {
    { EpiResid E{F.X, modl, gidx, coef}; run_gemm(F, A, Bt, SEQ, D, K, E); }
    if (with_ctx) {
        pg8::Gemm g{A, Bt, MT, D, K, 256}; pg8::SplitKOrder S{64, 4, K / 256, F.G, F.bx};
        EpiSlab E{F.SLAB, modl, gidx, coef};
        int tid2 = F.tid; asm volatile("" : "+v"(tid2));
        pg8::gemm_phase<EpiSlab, pg8::SplitKOrder, false, false>(F.lds, g, S, E, tid2);
    }
}
__device__ __forceinline__ void xpose_item(const float* W, int K, int N, bf16* WT, int kb, int nb, int dst_row0, LAS float* scr, int lane) {
    const int k0 = 64 * kb, n0 = 32 * nb;
    float tv[32];
#pragma unroll
    for (int i = 0; i < 32; ++i) tv[i] = W[(size_t)(k0 + 2 * i + (lane >> 5)) * N + n0 + (lane & 31)];
#pragma unroll
    for (int i = 0; i < 32; ++i) scr[(2 * i + (lane >> 5)) * 33 + (lane & 31)] = tv[i];
    LDS_WAIT(); asm volatile("" ::: "memory");
    const int c = lane & 7;
#pragma unroll
    for (int j = 0; j < 4; ++j) { const int n = (lane >> 3) + 8 * j; const LAS float* s = scr + (8 * c) * 33 + n;
        u32x4 o; o.x = pk2(s[0 * 33], s[1 * 33]); o.y = pk2(s[2 * 33], s[3 * 33]); o.z = pk2(s[4 * 33], s[5 * 33]); o.w = pk2(s[6 * 33], s[7 * 33]);
        *(u32x4*)(WT + (size_t)(dst_row0 + n) * K + k0 + 8 * c) = o; }
    LDS_WAIT(); asm volatile("" ::: "memory");
}

__device__ __forceinline__ void ph_prologue(const Fr& F) {
    LAS float* scr = (LAS float*)(F.lds + F.wave * 16384);
    const int gw = F.bx * 8 + F.wave, NGW = F.G * 8;
    constexpr int C1 = 22528, C2 = C1 + 11264, C3 = C2 + 3104, C4 = C3 + 1024, C5 = C4 + 1536, C6 = C5 + 768, C7 = C6 + 192, C8 = C7 + 192, C9 = C8 + 768, C10 = C9 + 512;
    for (int it = gw; it < C10; it += NGW) {
        if (it < C1) { const int mat = it / 2816, r = it % 2816, kb = r / 176, nb = r % 176, n0 = 32 * nb, half = n0 / DFF, jj = n0 % DFF;
            xpose_item(F.ffn_w_in + (size_t)mat * D * 2 * DFF, D, 2 * DFF, F.WFI + (size_t)mat * 2 * DFF * D, kb, nb, (jj / 128) * 256 + half * 128 + (jj % 128), scr, F.lane); }
        else if (it < C2) { const int q = it - C1, mat = q / 1408, r = q % 1408; xpose_item(F.ffn_w_out + (size_t)mat * DFF * D, DFF, D, F.WFO + (size_t)mat * D * DFF, r / 32, r % 32, 32 * (r % 32), scr, F.lane); }
        else if (it < C3) { const int q = it - C2, mat = q / 1552, r = q % 1552; xpose_item(F.gla_w_in + (size_t)mat * D * 3104, D, 3104, F.WGI + (size_t)mat * GLA_NP * D, r / 97, r % 97, 32 * (r % 97), scr, F.lane); }
        else if (it < C4) { const int q = it - C3, mat = q / 512, r = q % 512; xpose_item(F.gla_w_out + (size_t)mat * D * D, D, D, F.WGO + (size_t)mat * D * D, r / 32, r % 32, 32 * (r % 32), scr, F.lane); }
        else if (it < C5) { const int r = it - C4; xpose_item(F.rg_w_in, D, 3072, F.WRI, r / 96, r % 96, 32 * (r % 96), scr, F.lane); }
        else if (it < C6) { const int r = it - C5; xpose_item(F.rg_w_out, 1536, D, F.WRO, r / 32, r % 32, 32 * (r % 32), scr, F.lane); }
        else if (it < C7) { const int q = it - C6, mat = q / 8, r = q % 8; xpose_item(F.rg_w_a + (size_t)mat * 16384, 128, 128, F.WRA + (size_t)mat * 16384, r / 4, r % 4, 32 * (r % 4), scr, F.lane); }
        else if (it < C8) { const int q = it - C7, mat = q / 8, r = q % 8; xpose_item(F.rg_w_x + (size_t)mat * 16384, 128, 128, F.WRX + (size_t)mat * 16384, r / 4, r % 4, 32 * (r % 4), scr, F.lane); }
        else if (it < C9) { const int r = it - C8; xpose_item(F.swa_w_qkv, D, 1536, F.WSQ, r / 48, r % 48, 32 * (r % 48), scr, F.lane); }
        else { const int r = it - C9; xpose_item(F.swa_w_out, D, D, F.WSO, r / 32, r % 32, 32 * (r % 32), scr, F.lane); }
    }
    const int gt = F.bx * 512 + F.tid, NGT = F.G * 512;
    for (int i = gt; i < 2 * 224 * (D / 8); i += NGT) { const int mat = i / (224 * 128), r = i % (224 * 128); *(u32x4*)(F.WGI + (size_t)mat * GLA_NP * D + (size_t)3104 * D + (size_t)r * 8) = (u32x4){0u, 0u, 0u, 0u}; }
    for (int i = gt; i < MT * (D / 4); i += NGT) { const f32x4 v = (i < SEQ * (D / 4)) ? ((const f32x4*)F.x)[i] : ((const f32x4*)F.ctx)[i - SEQ * (D / 4)]; ((f32x4*)F.X)[i] = v; }
    if (gt == 0) *(unsigned*)(F.ws + 512 * 1024) = 0u;
    if (gt < 4096) { const int id = gt >> 4, f = gt & 15; const float freq = powf(10000.0f, -(float)(2 * f) / 32.0f); const float ang = (float)id * freq;
        const double rev = (double)ang * 0.15915494309189535; const float rr = (float)(rev - rint(rev));
        F.ROPE[2 * gt] = __builtin_amdgcn_cosf(rr); F.ROPE[2 * gt + 1] = __builtin_amdgcn_sinf(rr); }
    __syncthreads();
    LAS f32x4* red = (LAS f32x4*)F.lds;
    for (int b = F.bx; b < 4 * 72; b += F.G) {
        const int li = b / 72, c0 = (b % 72) * 128 + 2 * F.lane;
        const float* wp = F.ada_w + (size_t)li * D * NMODV + (size_t)(F.wave * 128) * NMODV + c0;
        float a0 = 0.f, a1 = 0.f, b0 = 0.f, b1 = 0.f;
#pragma unroll 32
        for (int k = 0; k < 128; ++k) { const f32x2 w = *(const f32x2*)(wp + (size_t)k * NMODV); const float sl = siluf_(F.c[F.wave * 128 + k]), sc = siluf_(F.c_ctx[F.wave * 128 + k]);
            a0 += sl * w.x; a1 += sl * w.y; b0 += sc * w.x; b1 += sc * w.y; }
        red[F.wave * 64 + F.lane] = (f32x4){a0, a1, b0, b1};
        __syncthreads();
        if (F.wave == 0) { f32x4 s = red[F.lane];
#pragma unroll
            for (int w = 1; w < 8; ++w) s += red[w * 64 + F.lane];
            const f32x2 bb = *(const f32x2*)(F.ada_b + (size_t)li * NMODV + c0);
            *(f32x2*)(F.MOD + (size_t)(li * 2 + 0) * NMODV + c0) = (f32x2){s[0] + bb.x, s[1] + bb.y};
            *(f32x2*)(F.MOD + (size_t)(li * 2 + 1) * NMODV + c0) = (f32x2){s[2] + bb.x, s[3] + bb.y}; }
        __syncthreads();
    }
}

__device__ __forceinline__ void ph_norm(const Fr& F, int layer, int k, int mrows, int nks) {
    const float* g = F.norm_g + (size_t)(layer * 3 + k) * D;
    const int gw = F.bx * 8 + F.wave, NGW = F.G * 8;
    f32x4 gs[4], sh[4];
    { const float* mod = F.MOD + (size_t)(layer * 2) * NMODV; const float* shift = mod + (3 * k) * 1024; const float* scale = mod + (3 * k + 1) * 1024;
#pragma unroll
      for (int j = 0; j < 4; ++j) { const int col = 4 * (F.lane + 64 * j); gs[j] = *(const f32x4*)(g + col) * (*(const f32x4*)(scale + col) + 1.0f); sh[j] = *(const f32x4*)(shift + col); } }
    int m = gw;
    f32x4 v[4];
    if (m < mrows) { const f32x4* xr = (const f32x4*)(F.X + (size_t)m * D) + F.lane;
#pragma unroll
        for (int j = 0; j < 4; ++j) v[j] = xr[64 * j]; }
    while (m < mrows) {
        const int mn = m + NGW;
        f32x4 vn[4];
        if (mn < mrows) { const f32x4* xr = (const f32x4*)(F.X + (size_t)mn * D) + F.lane;
#pragma unroll
            for (int j = 0; j < 4; ++j) vn[j] = xr[64 * j]; }
        f32x4 gsr[4], shr[4];
#pragma unroll
        for (int j = 0; j < 4; ++j) { gsr[j] = gs[j]; shr[j] = sh[j]; }
        if (m >= SEQ) {
            const float* mod = F.MOD + (size_t)(layer * 2 + 1) * NMODV; const float* shift = mod + (3 * k) * 1024; const float* scale = mod + (3 * k + 1) * 1024;
#pragma unroll
            for (int j = 0; j < 4; ++j) { const int col = 4 * (F.lane + 64 * j); gsr[j] = *(const f32x4*)(g + col) * (*(const f32x4*)(scale + col) + 1.0f); shr[j] = *(const f32x4*)(shift + col); }
            if (nks > 0) {
                for (int ks = 0; ks < nks; ks += 4) {
                    f32x4 t[4][4];
#pragma unroll
                    for (int i = 0; i < 4; ++i) { const f32x4* sp = (const f32x4*)(F.SLAB + ((size_t)(ks + i < nks ? ks + i : ks) * 256 + (m - SEQ)) * D) + F.lane;
#pragma unroll
                        for (int j = 0; j < 4; ++j) t[i][j] = sp[64 * j]; }
#pragma unroll
                    for (int i = 0; i < 4; ++i) if (ks + i < nks) {
#pragma unroll
                        for (int j = 0; j < 4; ++j) v[j] += t[i][j]; }
                }
                f32x4* xw = (f32x4*)(F.X + (size_t)m * D) + F.lane;
#pragma unroll
                for (int j = 0; j < 4; ++j) xw[64 * j] = v[j];
            }
        }
        float ss = 0.f;
#pragma unroll
        for (int j = 0; j < 4; ++j) ss += (v[j].x * v[j].x + v[j].y * v[j].y) + (v[j].z * v[j].z + v[j].w * v[j].w);
        const float rstd = __builtin_amdgcn_rsqf(wave_sum(ss, F.lane) * (1.0f / D) + NORM_EPS);
        u32x2* o8 = (u32x2*)(F.XN + (size_t)m * D) + F.lane;
#pragma unroll
        for (int j = 0; j < 4; ++j) { const f32x4 y = v[j] * rstd * gsr[j] + shr[j]; u32x2 w; w.x = pk2(y[0], y[1]); w.y = pk2(y[2], y[3]); o8[64 * j] = w; }
#pragma unroll
        for (int j = 0; j < 4; ++j) v[j] = vn[j];
        m = mn;
    }
}
__device__ __forceinline__ void ph_final(const Fr& F) {
    const int gw = F.bx * 8 + F.wave, NGW = F.G * 8;
    for (int m = gw; m < SEQ; m += NGW) {
        const f32x4* xr = (const f32x4*)(F.X + (size_t)m * D) + F.lane;
        f32x4 v[4]; float ss = 0.f;
#pragma unroll
        for (int j = 0; j < 4; ++j) { v[j] = xr[64 * j]; ss += (v[j].x * v[j].x + v[j].y * v[j].y) + (v[j].z * v[j].z + v[j].w * v[j].w); }
        const float rstd = __builtin_amdgcn_rsqf(wave_sum(ss, F.lane) * (1.0f / D) + NORM_EPS);
        f32x4* o = (f32x4*)(F.out + (size_t)m * D) + F.lane;
#pragma unroll
        for (int j = 0; j < 4; ++j) { const f32x4 gg = *(const f32x4*)(F.final_g + 4 * (F.lane + 64 * j)); o[64 * j] = v[j] * rstd * gg; }
    }
}

__device__ __forceinline__ void gla_b_unit(const Fr& F, int j, int n, int h, int z) {
    LAS unsigned char* lds = F.lds;
    LAS float* sLR = (LAS float*)(lds);
    LAS float* sW = (LAS float*)(lds + 4096);
    LAS float* sB = (LAS float*)(lds + 12288);
    LAS float* sSeg = (LAS float*)(lds + 45056);
    LAS bf16* sVT = (LAS bf16*)(lds + 47104);
    LAS bf16* sKT = (LAS bf16*)(lds + 83968);
    const int tid = F.tid, row0 = 64 * n;
    float lrv[2], wav[4];
#pragma unroll
    for (int i = 0; i < 2; ++i) { const int ii = tid + 512 * i, t = ii >> 4, r = ii & 15; lrv[i] = F.LR[(size_t)(row0 + t) * 32 + z * 16 + r]; }
#pragma unroll
    for (int i = 0; i < 4; ++i) { const int ii = tid + 512 * i, r = ii >> 7, k = ii & 127; wav[i] = F.gla_w_a2[((size_t)(j * 2 + z) * 16 + r) * 512 + h * 128 + k]; }
    const int tS = tid >> 3, d0S = (tid & 7) * 16, rowS = row0 + tS, e0S = (tid & 7) * 32;
    const bf16* qpS = F.P + (size_t)rowS * 3072 + h * 128 + d0S;
    const bf16x8 q0 = *(const bf16x8*)qpS, q1 = *(const bf16x8*)(qpS + 8), k0 = *(const bf16x8*)(qpS + 512), k1 = *(const bf16x8*)(qpS + 520);
    const bf16* vpS = F.P + (size_t)rowS * 3072 + 1024 + h * 256 + e0S;
    const bf16x8 vv0 = *(const bf16x8*)vpS, vv1 = *(const bf16x8*)(vpS + 8), vv2 = *(const bf16x8*)(vpS + 16), vv3 = *(const bf16x8*)(vpS + 24);
    const float bias = F.gla_b_a[(size_t)(j * 2 + z) * 512 + h * 128 + (tid & 127)];
#pragma unroll
    for (int i = 0; i < 2; ++i) sLR[tid + 512 * i] = lrv[i];
#pragma unroll
    for (int i = 0; i < 4; ++i) sW[tid + 512 * i] = wav[i];
#pragma unroll
    for (int i = 0; i < 8; ++i) { sVT[(e0S + i) * 72 + tS] = (unsigned short)vv0[i]; sVT[(e0S + 8 + i) * 72 + tS] = (unsigned short)vv1[i]; sVT[(e0S + 16 + i) * 72 + tS] = (unsigned short)vv2[i]; sVT[(e0S + 24 + i) * 72 + tS] = (unsigned short)vv3[i]; }
    __syncthreads();
    {
        const int k = tid & 127, tq = tid >> 7;
        float wv[16];
#pragma unroll
        for (int r = 0; r < 16; ++r) wv[r] = sW[r * 128 + k];
        float gv[16];
#pragma unroll
        for (int i = 0; i < 16; ++i) { const int t = tq * 16 + i; float a = bias;
            const f32x4 l0 = *(const LAS f32x4*)(sLR + t * 16), l1 = *(const LAS f32x4*)(sLR + t * 16 + 4), l2 = *(const LAS f32x4*)(sLR + t * 16 + 8), l3 = *(const LAS f32x4*)(sLR + t * 16 + 12);
#pragma unroll
            for (int r = 0; r < 4; ++r) { a += l0[r] * wv[r]; a += l1[r] * wv[4 + r]; a += l2[r] * wv[8 + r]; a += l3[r] * wv[12 + r]; }
            gv[i] = logsigmoid_(a) * (1.0f / 16.0f); }
        float run = 0.f;
        if (z == 0) {
#pragma unroll
            for (int i = 0; i < 16; ++i) { run += gv[i]; gv[i] = run; }
        } else {
#pragma unroll
            for (int i = 15; i >= 0; --i) { run += gv[i]; gv[i] = run; }
        }
        sSeg[tq * 128 + k] = run;
        __syncthreads();
        float off = 0.f;
#pragma unroll
        for (int q = 0; q < 4; ++q) { const float sv = sSeg[q * 128 + k]; if (z == 0 ? (q < tq) : (q > tq)) off += sv; }
#pragma unroll
        for (int i = 0; i < 16; ++i) sB[(tq * 16 + i) * 128 + k] = gv[i] + off;
    }
    __syncthreads();
    const int tl = (z == 0) ? 63 : 0;
    {
        const int t = tid >> 3, d0 = (tid & 7) * 16, row = row0 + t;
        float qd[16], kn[16];
#pragma unroll
        for (int i = 0; i < 16; ++i) {
            const float bt = sB[t * 128 + d0 + i], bl = sB[tl * 128 + d0 + i];
            const float qv = bf2f((unsigned short)(i < 8 ? q0[i] : q1[i - 8])), kv = bf2f((unsigned short)(i < 8 ? k0[i] : k1[i - 8]));
            qd[i] = qv * __expf(bt); kn[i] = kv * __expf(-bt);
            sKT[(d0 + i) * 72 + t] = f2bf1(kv * __expf(bl - bt));
        }
        u32x4 w0, w1;
        w0.x = pk2(qd[0], qd[1]); w0.y = pk2(qd[2], qd[3]); w0.z = pk2(qd[4], qd[5]); w0.w = pk2(qd[6], qd[7]);
        w1.x = pk2(qd[8], qd[9]); w1.y = pk2(qd[10], qd[11]); w1.z = pk2(qd[12], qd[13]); w1.w = pk2(qd[14], qd[15]);
        bf16* qo = F.QD + ((size_t)(z * NCH + n) * 4 + h) * 8192 + (row - row0) * 128 + d0;       *(u32x4*)qo = w0; *(u32x4*)(qo + 8) = w1;
        w0.x = pk2(kn[0], kn[1]); w0.y = pk2(kn[2], kn[3]); w0.z = pk2(kn[4], kn[5]); w0.w = pk2(kn[6], kn[7]);
        w1.x = pk2(kn[8], kn[9]); w1.y = pk2(kn[10], kn[11]); w1.z = pk2(kn[12], kn[13]); w1.w = pk2(kn[14], kn[15]);
        bf16* ko = F.KN + ((size_t)(z * NCH + n) * 4 + h) * 8192 + (row - row0) * 128 + d0; *(u32x4*)ko = w0; *(u32x4*)(ko + 8) = w1;
        if (tid < 128) F.DEC[(size_t)(z * NCH + n) * 512 + h * 128 + tid] = __expf(sB[tl * 128 + tid]);
    }
    __syncthreads();
    {
        const int r = F.lane & 15, q = F.lane >> 4, w = F.wave;
        const bf16x8 a0 = *(const LAS bf16x8*)(sKT + (w * 16 + r) * 72 + q * 8), a1 = *(const LAS bf16x8*)(sKT + (w * 16 + r) * 72 + 32 + q * 8);
        bf16* USp = F.US + ((size_t)(z * NCH + n) * 4 + h) * 32768;
#pragma unroll 4
        for (int et = 0; et < 16; ++et) {
            const bf16x8 b0 = *(const LAS bf16x8*)(sVT + (et * 16 + r) * 72 + q * 8), b1 = *(const LAS bf16x8*)(sVT + (et * 16 + r) * 72 + 32 + q * 8);
            f32x4 acc = {0.f, 0.f, 0.f, 0.f}; acc = mma(a0, b0, acc); acc = mma(a1, b1, acc);
            u32x2 o; o.x = pk2(acc[0], acc[1]); o.y = pk2(acc[2], acc[3]);
            *(u32x2*)(USp + (size_t)((et * 8 + w) * 16 + r) * 16 + 4 * q) = o;
        }
    }
    __syncthreads();
}
__device__ __forceinline__ void gla_scan(const Fr& F) {
    for (int idx = F.bx * 512 + F.tid; idx < 131072; idx += F.G * 512) {
        const int o2 = 2 * (idx & 16383), h = (idx >> 14) & 3, z = idx >> 16, dd = ((o2 >> 8) & 7) * 16 + (o2 & 15);
        float s0 = 0.f, s1 = 0.f;
        constexpr int NB = 13;
        unsigned uA[NB], uB[NB]; f32x2 dA[NB], dB[NB]; unsigned *pA[NB], *pB[NB];
#define GS_LOAD(U, Dc, P, s_) { _Pragma("unroll") for (int i = 0; i < NB; ++i) { const int ss = (s_) + i, n = z ? (NCH - 1 - ss) : (ss < 4 ? 256 + ss : ss - 4); \
            P[i] = (unsigned*)(F.US + ((size_t)(z * NCH + n) * 4 + h) * 32768 + o2); U[i] = *P[i]; \
            Dc[i] = *(const f32x2*)(F.DEC + (size_t)(z * NCH + n) * 512 + h * 128 + dd); } }
#define GS_PROC(U, Dc, P) { _Pragma("unroll") for (int i = 0; i < NB; ++i) { *P[i] = pk2(s0, s1); s0 = Dc[i].x * s0 + bflo(U[i]); s1 = Dc[i].y * s1 + bfhi(U[i]); } }
        GS_LOAD(uA, dA, pA, 0)
#pragma unroll 1
        for (int s = 0; s < NCH; s += 2 * NB) {
            GS_LOAD(uB, dB, pB, s + NB)
            GS_PROC(uA, dA, pA)
            if (s + 2 * NB < NCH) GS_LOAD(uA, dA, pA, s + 2 * NB)
            GS_PROC(uB, dB, pB)
        }
#undef GS_LOAD
#undef GS_PROC
    }
}
__device__ __forceinline__ void gla_d_unit(const Fr& F, int j, int n, int h) {
    LAS unsigned char* lds = F.lds;
    LAS bf16* sVT = (LAS bf16*)(lds);
    LAS bf16* sAtt = (LAS bf16*)(lds + 36864);
    LAS float* sSS = (LAS float*)(lds + 55296);
    const int tid = F.tid, row0 = 64 * n, r = F.lane & 15, q = F.lane >> 4, w = F.wave;
    bf16x8 usf[2][4][2];
#pragma unroll
    for (int z = 0; z < 2; ++z) { const bf16* USz = F.US + ((size_t)(z * NCH + n) * 4 + h) * 32768;
#pragma unroll
        for (int ks = 0; ks < 4; ++ks) { const int dt = 2 * ks + (q >> 1), dl = 8 * (q & 1);
            usf[z][ks][0] = *(const bf16x8*)(USz + (size_t)(((2 * w) * 8 + dt) * 16 + r) * 16 + dl); usf[z][ks][1] = *(const bf16x8*)(USz + (size_t)(((2 * w + 1) * 8 + dt) * 16 + r) * 16 + dl); } }
    {
        const int t = tid >> 3, e0 = (tid & 7) * 32;
        const bf16* vp = F.P + (size_t)(row0 + t) * 3072 + 1024 + h * 256 + e0;
#pragma unroll
        for (int c = 0; c < 4; ++c) { const bf16x8 vv = *(const bf16x8*)(vp + 8 * c);
#pragma unroll
            for (int i = 0; i < 8; ++i) sVT[(e0 + 8 * c + i) * 72 + t] = (unsigned short)vv[i]; }
    }
    {
        const int z = w >> 2, tt = w & 3;
        const bf16* qdp = F.QD + ((size_t)(z * NCH + n) * 4 + h) * 8192 + (tt * 16 + r) * 128 + 8 * q;
        bf16x8 bq[4];
#pragma unroll
        for (int ks = 0; ks < 4; ++ks) bq[ks] = *(const bf16x8*)(qdp + 32 * ks);
        const int t = tt * 16 + r;
#pragma unroll
        for (int st = 0; st < 4; ++st) {
            const bf16* knp = F.KN + ((size_t)(z * NCH + n) * 4 + h) * 8192 + (st * 16 + r) * 128 + 8 * q;
            f32x4 acc = {0.f, 0.f, 0.f, 0.f};
#pragma unroll
            for (int ks = 0; ks < 4; ++ks) acc = mma(*(const bf16x8*)(knp + 32 * ks), bq[ks], acc);
#pragma unroll
            for (int jj = 0; jj < 4; ++jj) { const int s = st * 16 + 4 * q + jj; const bool keep = (z == 0) ? (s <= t) : (s >= t); if (!keep) acc[jj] = 0.f; }
            u32x2 o; o.x = pk2(acc[0], acc[1]); o.y = pk2(acc[2], acc[3]);
            *(LAS u32x2*)(sAtt + (z * 64 + t) * 72 + st * 16 + 4 * q) = o;
        }
    }
    __syncthreads();
    f32x4 acc[2][4];
#pragma unroll
    for (int ei = 0; ei < 2; ++ei)
#pragma unroll
        for (int tt = 0; tt < 4; ++tt) acc[ei][tt] = (f32x4){0.f, 0.f, 0.f, 0.f};
#pragma unroll
    for (int z = 0; z < 2; ++z) {
#pragma unroll
        for (int ks = 0; ks < 2; ++ks) {
            const bf16x8 a0 = *(const LAS bf16x8*)(sVT + (32 * w + r) * 72 + ks * 32 + 8 * q), a1 = *(const LAS bf16x8*)(sVT + (32 * w + 16 + r) * 72 + ks * 32 + 8 * q);
#pragma unroll
            for (int tt = 0; tt < 4; ++tt) { const bf16x8 b = *(const LAS bf16x8*)(sAtt + (z * 64 + tt * 16 + r) * 72 + ks * 32 + 8 * q);
                acc[0][tt] = mma(a0, b, acc[0][tt]); acc[1][tt] = mma(a1, b, acc[1][tt]); }
        }
        const bf16* QDz = F.QD + ((size_t)(z * NCH + n) * 4 + h) * 8192 + r * 128 + 8 * q;
#pragma unroll
        for (int ks = 0; ks < 4; ++ks) {
            const bf16x8 a0 = usf[z][ks][0], a1 = usf[z][ks][1];
#pragma unroll
            for (int tt = 0; tt < 4; ++tt) { const bf16x8 b = *(const bf16x8*)(QDz + (size_t)(tt * 16) * 128 + ks * 32);
                acc[0][tt] = mma(a0, b, acc[0][tt]); acc[1][tt] = mma(a1, b, acc[1][tt]); }
        }
    }
#pragma unroll
    for (int tt = 0; tt < 4; ++tt) {
        float ss = 0.f;
#pragma unroll
        for (int ei = 0; ei < 2; ++ei)
#pragma unroll
            for (int jj = 0; jj < 4; ++jj) ss += acc[ei][tt][jj] * acc[ei][tt][jj];
        ss += shx(ss, 16, F.lane); ss += shx(ss, 32, F.lane);
        if (q == 0) sSS[w * 64 + tt * 16 + r] = ss;
    }
    __syncthreads();
#pragma unroll
    for (int tt = 0; tt < 4; ++tt) {
        float tot = 0.f;
#pragma unroll
        for (int ww = 0; ww < 8; ++ww) tot += sSS[ww * 64 + tt * 16 + r];
        const float rstd = __builtin_amdgcn_rsqf(tot * (1.0f / 256.0f) + NORM_EPS);
        const size_t row = (size_t)(row0 + tt * 16 + r);
#pragma unroll
        for (int ei = 0; ei < 2; ++ei) {
            const int e = 32 * w + 16 * ei + 4 * q;
            const f32x4 g4 = *(const f32x4*)(F.gla_norm_g + (size_t)j * 256 + e);
            const u32x2 og = *(const u32x2*)(F.P + row * 3072 + 2048 + h * 256 + e);
            const float o0 = acc[ei][tt][0] * rstd * g4[0] * siluf_(bflo(og.x)), o1 = acc[ei][tt][1] * rstd * g4[1] * siluf_(bfhi(og.x));
            const float o2 = acc[ei][tt][2] * rstd * g4[2] * siluf_(bflo(og.y)), o3 = acc[ei][tt][3] * rstd * g4[3] * siluf_(bfhi(og.y));
            u32x2 o; o.x = pk2(o0, o1); o.y = pk2(o2, o3);
            *(u32x2*)(F.OB + row * 1024 + h * 256 + e) = o;
        }
    }
    __syncthreads();
}

__device__ __forceinline__ void rg_unit(const Fr& F, int n, int nb, int mode, int buf) {
    LAS unsigned char* lds = F.lds;
    LAS bf16* sXC = (LAS bf16*)(lds + buf * 17408);
    const int tid = F.tid, row0 = 64 * n, w = F.wave;
    LAS float* sA = (LAS float*)(lds + 34816 + w * 12288);
    LAS float* sU = sA + 1024;
    LAS float* sHS = sA + 2048;
    const int lo = (n >= 256) ? SEQ : 0, hi = (n >= 256) ? MT : SEQ;
    {
        const int cc = tid & 127, tq = tid >> 7, c = 128 * nb + cc;
        const float w0 = F.rg_conv_w[0 * 1536 + c], w1 = F.rg_conv_w[1 * 1536 + c], w2 = F.rg_conv_w[2 * 1536 + c], w3 = F.rg_conv_w[3 * 1536 + c], cb = F.rg_conv_b[c];
        const int tb = row0 + tq * 16;
        float xm2, xm1, x0, xp1;
        { const int r = tb - 2; xm2 = (r >= lo && r < hi) ? bf2f(F.XR[(size_t)r * 1536 + c]) : 0.f; }
        { const int r = tb - 1; xm1 = (r >= lo && r < hi) ? bf2f(F.XR[(size_t)r * 1536 + c]) : 0.f; }
        x0 = bf2f(F.XR[(size_t)tb * 1536 + c]);
#pragma unroll
        for (int i = 0; i < 16; ++i) {
            const int r = tb + i + 1; xp1 = (r < hi) ? bf2f(F.XR[(size_t)r * 1536 + c]) : 0.f;
            const float xc = cb + w0 * xm2 + w1 * xm1 + w2 * x0 + w3 * xp1;
            sXC[(tq * 16 + i) * 136 + cc] = f2bf1(xc);
            xm2 = xm1; xm1 = x0; x0 = xp1;
        }
    }
    __syncthreads();
    const int r = F.lane & 15, q = F.lane >> 4;
    const int c16 = 128 * nb + 16 * w;
#pragma unroll 1
    for (int z = 0; z < 2; ++z) {
        {
            const bf16* wa = F.WRA + ((size_t)(z * 12 + nb) * 128 + 16 * w + r) * 128 + 8 * q;
            const bf16* wx = F.WRX + ((size_t)(z * 12 + nb) * 128 + 16 * w + r) * 128 + 8 * q;
            f32x4 ra[4], ia[4];
#pragma unroll
            for (int tt = 0; tt < 4; ++tt) { ra[tt] = (f32x4){0.f, 0.f, 0.f, 0.f}; ia[tt] = (f32x4){0.f, 0.f, 0.f, 0.f}; }
#pragma unroll
            for (int ks = 0; ks < 4; ++ks) {
                const bf16x8 ar = *(const bf16x8*)(wa + 32 * ks), ai = *(const bf16x8*)(wx + 32 * ks);
#pragma unroll
                for (int tt = 0; tt < 4; ++tt) { const bf16x8 b = *(const LAS bf16x8*)(sXC + (tt * 16 + r) * 136 + ks * 32 + 8 * q); ra[tt] = mma(ar, b, ra[tt]); ia[tt] = mma(ai, b, ia[tt]); }
            }
            const int cl = 16 * w + 4 * q, c4 = 128 * nb + cl;
            const f32x4 ba = *(const f32x4*)(F.rg_b_a + z * 1536 + c4), bx = *(const f32x4*)(F.rg_b_x + z * 1536 + c4), lam = *(const f32x4*)(F.rg_lam + z * 1536 + c4);
            f32x4 coef;
#pragma unroll
            for (int jj = 0; jj < 4; ++jj) coef[jj] = -8.0f * softplus_(-lam[jj]);
#pragma unroll
            for (int tt = 0; tt < 4; ++tt) {
                const int t = tt * 16 + r;
                const u32x2 xw = *(const LAS u32x2*)(sXC + t * 136 + cl);
                const float xc[4] = {bflo(xw.x), bfhi(xw.x), bflo(xw.y), bfhi(xw.y)};
                f32x4 av, uv, lav;
#pragma unroll
                for (int jj = 0; jj < 4; ++jj) {
                    const float rr = sigmoidf_(ra[tt][jj] + ba[jj]), ii = sigmoidf_(ia[tt][jj] + bx[jj]);
                    const float la = coef[jj] * rr, x2 = 2.0f * la;
                    const float a = __expf(la);
                    const float ser = -x2 * (1.0f + x2 * (0.5f + x2 * (0.16666667f + x2 * (0.041666668f + x2 * 0.008333334f))));
                    const float om = (x2 > -0.25f) ? ser : (1.0f - a * a);
                    av[jj] = a; uv[jj] = __builtin_amdgcn_sqrtf(om) * (ii * xc[jj]); lav[jj] = la;
                }
                *(LAS f32x4*)(sA + t * 16 + 4 * q) = av; *(LAS f32x4*)(sU + t * 16 + 4 * q) = uv;
                { const size_t go = (((size_t)(z * NCH + n) * 12 + nb) * 8 + w) * 1024 + (size_t)t * 16 + 4 * q; u32x2 lw, uw; lw.x = pk2(lav[0], lav[1]); lw.y = pk2(lav[2], lav[3]); uw.x = pk2(uv[0], uv[1]); uw.y = pk2(uv[2], uv[3]);
                  *(u32x2*)(F.LAg + go) = lw; *(u32x2*)(F.UUg + go) = uw; }
            }
        }
        asm volatile("s_waitcnt lgkmcnt(0)" ::: "memory");
        {
            const int cl = F.lane & 15, seg = F.lane >> 4, c = c16 + cl;
            float Pp = 1.f, Hh = 0.f;
            if (z == 0) {
#pragma unroll
                for (int i = 0; i < 16; ++i) { const int t = seg * 16 + i; const float a = sA[t * 16 + cl], u = sU[t * 16 + cl]; Hh = a * Hh + u; Pp *= a; } }
            else {
#pragma unroll
                for (int i = 15; i >= 0; --i) { const int t = seg * 16 + i; const float a = sA[t * 16 + cl], u = sU[t * 16 + cl]; Hh = a * Hh + u; Pp *= a; } }
            float sp[4], sh[4];
            sp[0] = Pp; sh[0] = Hh;
            sp[1] = shx(Pp, 16, F.lane); sh[1] = shx(Hh, 16, F.lane);
            sp[2] = shx(Pp, 32, F.lane); sh[2] = shx(Hh, 32, F.lane);
            sp[3] = shx(Pp, 48, F.lane); sh[3] = shx(Hh, 48, F.lane);
            if (mode == 0) {
                float Pt = 1.f, Ht = 0.f;
#pragma unroll
                for (int s2 = 0; s2 < 4; ++s2) { const int sg = (z == 0) ? s2 : 3 - s2;
                    float p_ = sp[0], h_ = sh[0];
#pragma unroll
                    for (int x = 1; x < 4; ++x) if ((seg ^ x) == sg) { p_ = sp[x]; h_ = sh[x]; }
                    Ht = p_ * Ht + h_; Pt *= p_; }
                if (seg == 0) { F.AP[(size_t)(z * NCH + n) * 1536 + c] = Pt; F.HE[(size_t)(z * NCH + n) * 1536 + c] = Ht; }
            } else {
                float hh = F.CIN[(size_t)(z * NCH + n) * 1536 + c];
#pragma unroll
                for (int s2 = 0; s2 < 4; ++s2) { const int sg = (z == 0) ? s2 : 3 - s2; const bool prior = (z == 0) ? (sg < seg) : (sg > seg);
                    float p_ = sp[0], h_ = sh[0];
#pragma unroll
                    for (int x = 1; x < 4; ++x) if ((seg ^ x) == sg) { p_ = sp[x]; h_ = sh[x]; }
                    if (prior) hh = p_ * hh + h_; }
                if (z == 0) {
#pragma unroll
                    for (int i = 0; i < 16; ++i) { const int t = seg * 16 + i; hh = sA[t * 16 + cl] * hh + sU[t * 16 + cl]; sHS[t * 16 + cl] = hh; } }
                else {
#pragma unroll
                    for (int i = 15; i >= 0; --i) { const int t = seg * 16 + i; hh = sA[t * 16 + cl] * hh + sU[t * 16 + cl]; sHS[t * 16 + cl] += hh; } }
            }
        }
        asm volatile("s_waitcnt lgkmcnt(0)" ::: "memory");
    }
    if (mode == 1) {
        const int t = F.lane; const size_t row = (size_t)(row0 + t);
        const u32x4 g0 = *(const u32x4*)(F.GG + row * 1536 + c16), g1 = *(const u32x4*)(F.GG + row * 1536 + c16 + 8);
        const f32x4 h0 = *(const LAS f32x4*)(sHS + t * 16), h1 = *(const LAS f32x4*)(sHS + t * 16 + 4), h2 = *(const LAS f32x4*)(sHS + t * 16 + 8), h3 = *(const LAS f32x4*)(sHS + t * 16 + 12);
        u32x4 o0, o1;
        o0.x = pk2(h0[0] * bflo(g0.x), h0[1] * bfhi(g0.x)); o0.y = pk2(h0[2] * bflo(g0.y), h0[3] * bfhi(g0.y)); o0.z = pk2(h1[0] * bflo(g0.z), h1[1] * bfhi(g0.z)); o0.w = pk2(h1[2] * bflo(g0.w), h1[3] * bfhi(g0.w));
        o1.x = pk2(h2[0] * bflo(g1.x), h2[1] * bfhi(g1.x)); o1.y = pk2(h2[2] * bflo(g1.y), h2[3] * bfhi(g1.y)); o1.z = pk2(h3[0] * bflo(g1.z), h3[1] * bfhi(g1.z)); o1.w = pk2(h3[2] * bflo(g1.w), h3[3] * bfhi(g1.w));
        *(u32x4*)(F.OB + row * 1536 + c16) = o0; *(u32x4*)(F.OB + row * 1536 + c16 + 8) = o1;
        asm volatile("s_waitcnt lgkmcnt(0)" ::: "memory");
    }
}
template <int CTRL, int RMASK> __device__ __forceinline__ float dppf(float oldv, float src) {
    return __builtin_bit_cast(float, __builtin_amdgcn_update_dpp(__builtin_bit_cast(int, oldv), __builtin_bit_cast(int, src), CTRL, RMASK, 0xf, false)); }
template <int CTRL, int RMASK> __device__ __forceinline__ void scan_step(float& P, float& H) {
    const float Pp = dppf<CTRL, RMASK>(1.0f, P), Hp = dppf<CTRL, RMASK>(0.0f, H);
    H = P * Hp + H; P = P * Pp; }
__device__ __forceinline__ void rg_unit1(const Fr& F, int n, int nb) {
    const int row0 = 64 * n, c16 = 128 * nb + 16 * F.wave, lane = F.lane;
    float hs[16];
#pragma unroll
    for (int z = 0; z < 2; ++z) {
        const int t = z ? 63 - lane : lane;
        const size_t go = (((size_t)(z * NCH + n) * 12 + nb) * 8 + F.wave) * 1024 + (size_t)t * 16;
        const u32x4 l0 = *(const u32x4*)(F.LAg + go), l1 = *(const u32x4*)(F.LAg + go + 8), u0 = *(const u32x4*)(F.UUg + go), u1 = *(const u32x4*)(F.UUg + go + 8);
        const float* cp = F.CIN + (size_t)(z * NCH + n) * 1536 + c16;
        const f32x4 ci0 = *(const f32x4*)cp, ci1 = *(const f32x4*)(cp + 4), ci2 = *(const f32x4*)(cp + 8), ci3 = *(const f32x4*)(cp + 12);
        float P[16], H[16], ci[16];
#pragma unroll
        for (int k = 0; k < 4; ++k) { P[2 * k] = __expf(bflo(l0[k])); P[2 * k + 1] = __expf(bfhi(l0[k])); P[8 + 2 * k] = __expf(bflo(l1[k])); P[8 + 2 * k + 1] = __expf(bfhi(l1[k]));
            H[2 * k] = bflo(u0[k]); H[2 * k + 1] = bfhi(u0[k]); H[8 + 2 * k] = bflo(u1[k]); H[8 + 2 * k + 1] = bfhi(u1[k]);
            ci[k] = ci0[k]; ci[4 + k] = ci1[k]; ci[8 + k] = ci2[k]; ci[12 + k] = ci3[k]; }
#pragma unroll
        for (int ch = 0; ch < 16; ++ch) {
            float p = P[ch], h = H[ch];
            scan_step<0x111, 0xf>(p, h); scan_step<0x112, 0xf>(p, h); scan_step<0x114, 0xf>(p, h); scan_step<0x118, 0xf>(p, h);
            scan_step<0x142, 0xa>(p, h); scan_step<0x143, 0xc>(p, h);
            const float hv = p * ci[ch] + h;
            if (z == 0) hs[ch] = hv;
            else hs[ch] += __builtin_bit_cast(float, __builtin_amdgcn_ds_bpermute((63 - lane) << 2, __builtin_bit_cast(int, hv)));
        }
    }
    const size_t ro = (size_t)(row0 + lane) * 1536 + c16;
    const u32x4 g0 = *(const u32x4*)(F.GG + ro), g1 = *(const u32x4*)(F.GG + ro + 8);
    u32x4 o0, o1;
    o0.x = pk2(hs[0] * bflo(g0.x), hs[1] * bfhi(g0.x)); o0.y = pk2(hs[2] * bflo(g0.y), hs[3] * bfhi(g0.y)); o0.z = pk2(hs[4] * bflo(g0.z), hs[5] * bfhi(g0.z)); o0.w = pk2(hs[6] * bflo(g0.w), hs[7] * bfhi(g0.w));
    o1.x = pk2(hs[8] * bflo(g1.x), hs[9] * bfhi(g1.x)); o1.y = pk2(hs[10] * bflo(g1.y), hs[11] * bfhi(g1.y)); o1.z = pk2(hs[12] * bflo(g1.z), hs[13] * bfhi(g1.z)); o1.w = pk2(hs[14] * bflo(g1.w), hs[15] * bfhi(g1.w));
    *(u32x4*)(F.OB + ro) = o0; *(u32x4*)(F.OB + ro + 8) = o1;
}
__device__ __forceinline__ void rg_carry(const Fr& F) {
    const int lane = F.lane;
    for (int sq = F.bx * 8 + F.wave; sq < 3072; sq += F.G * 8) {
        const int z = sq / 1536, c = sq % 1536;
        float ap[5], he[5]; size_t off[5];
        float Pl = 1.f, Hl = 0.f;
#pragma unroll
        for (int i = 0; i < 5; ++i) { const int ss = 5 * lane + i; const bool ok = ss < NCH; const int sc = ok ? ss : 0, n = z ? (NCH - 1 - sc) : (sc < 4 ? 256 + sc : sc - 4);
            off[i] = (size_t)(z * NCH + n) * 1536 + c; ap[i] = ok ? F.AP[off[i]] : 1.f; he[i] = ok ? F.HE[off[i]] : 0.f; }
#pragma unroll
        for (int i = 0; i < 5; ++i) { Hl = ap[i] * Hl + he[i]; Pl *= ap[i]; }
        float Pi = Pl, Hi = Hl;
#pragma unroll
        for (int o = 1; o < 64; o <<= 1) {
            const int src = lane - o;
            const float Pp = __builtin_bit_cast(float, __builtin_amdgcn_ds_bpermute((src < 0 ? lane : src) << 2, __builtin_bit_cast(int, Pi)));
            const float Hp = __builtin_bit_cast(float, __builtin_amdgcn_ds_bpermute((src < 0 ? lane : src) << 2, __builtin_bit_cast(int, Hi)));
            if (src >= 0) { Hi = Pi * Hp + Hi; Pi = Pi * Pp; }
        }
        float hh = __builtin_bit_cast(float, __builtin_amdgcn_ds_bpermute((lane > 0 ? lane - 1 : 0) << 2, __builtin_bit_cast(int, Hi)));
        if (lane == 0) hh = 0.f;
#pragma unroll
        for (int i = 0; i < 5; ++i) { if (5 * lane + i < NCH) F.CIN[off[i]] = hh; hh = ap[i] * hh + he[i]; }
    }
}

__device__ __forceinline__ void swa_unit(const Fr& F, int qb, int kvh) {
    LAS unsigned char* lds = F.lds;
    LAS bf16* sK = (LAS bf16*)(lds);
    LAS bf16* sVT = (LAS bf16*)(lds + 9216);
    const int tid = F.tid, row0 = 64 * qb, r = F.lane & 15, q = F.lane >> 4, w = F.wave;
    const bool is_ctx = qb >= 256;
    const int hq = kvh * 4 + (w >> 1), qoff = 32 * (w & 1);
    bf16x8 bq[2][2];
#pragma unroll
    for (int qt = 0; qt < 2; ++qt)
#pragma unroll
        for (int ks = 0; ks < 2; ++ks) bq[qt][ks] = *(const bf16x8*)(F.QKV + (size_t)(row0 + qoff + 16 * qt + r) * 1536 + hq * 64 + 32 * ks + 8 * q);
    float mrun[2], lrun[2];
    f32x4 o[4][2];
    { const float sk = F.swa_sink[hq]; mrun[0] = sk; mrun[1] = sk; lrun[0] = (q == 0) ? 1.f : 0.f; lrun[1] = lrun[0]; }
#pragma unroll
    for (int dt = 0; dt < 4; ++dt) { o[dt][0] = (f32x4){0.f, 0.f, 0.f, 0.f}; o[dt][1] = (f32x4){0.f, 0.f, 0.f, 0.f}; }
    const int ntiles = is_ctx ? 4 : 9;
#pragma unroll 1
    for (int ti = 0; ti < ntiles; ++ti) {
        int krow0; bool local;
        if (ti < 4) { krow0 = SEQ + 64 * ti; local = false; }
        else { krow0 = row0 - 128 + 64 * (ti - 4); local = true; if (krow0 < 0 || krow0 >= SEQ) continue; }
        __syncthreads();
        {
            const int key = tid >> 3, d0 = (tid & 7) * 8;
            const bf16* kp = F.QKV + (size_t)(krow0 + key) * 1536 + 1024 + kvh * 64 + d0;
            *(LAS bf16x8*)(sK + key * 72 + d0) = *(const bf16x8*)kp;
            const bf16x8 vv = *(const bf16x8*)(kp + 256);
#pragma unroll
            for (int i = 0; i < 8; ++i) sVT[(d0 + i) * 72 + key] = (unsigned short)vv[i];
        }
        __syncthreads();
        f32x4 st[4][2];
#pragma unroll
        for (int kt = 0; kt < 4; ++kt) {
            const bf16x8 a0 = *(const LAS bf16x8*)(sK + (16 * kt + r) * 72 + 8 * q), a1 = *(const LAS bf16x8*)(sK + (16 * kt + r) * 72 + 32 + 8 * q);
#pragma unroll
            for (int qt = 0; qt < 2; ++qt) { f32x4 a = {0.f, 0.f, 0.f, 0.f}; a = mma(a0, bq[qt][0], a); a = mma(a1, bq[qt][1], a); st[kt][qt] = a; }
        }
        if (local) {
#pragma unroll
            for (int kt = 0; kt < 4; ++kt)
#pragma unroll
                for (int qt = 0; qt < 2; ++qt)
#pragma unroll
                    for (int jj = 0; jj < 4; ++jj) { const int kpos = krow0 + 16 * kt + 4 * q + jj, qpos = row0 + qoff + 16 * qt + r; const int dd = kpos - qpos; if (dd > 128 || dd < -128) st[kt][qt][jj] = -1e30f; }
        }
#pragma unroll
        for (int qt = 0; qt < 2; ++qt) {
            float tm = -1e30f;
#pragma unroll
            for (int kt = 0; kt < 4; ++kt)
#pragma unroll
                for (int jj = 0; jj < 4; ++jj) tm = fmaxf(tm, st[kt][qt][jj]);
            tm = fmaxf(tm, shx(tm, 16, F.lane)); tm = fmaxf(tm, shx(tm, 32, F.lane));
            const float mn = fmaxf(mrun[qt], tm), alpha = __expf(mrun[qt] - mn);
            mrun[qt] = mn; float ls = lrun[qt] * alpha;
#pragma unroll
            for (int dt = 0; dt < 4; ++dt) o[dt][qt] *= alpha;
#pragma unroll
            for (int kt = 0; kt < 4; ++kt)
#pragma unroll
                for (int jj = 0; jj < 4; ++jj) { const float p = __expf(st[kt][qt][jj] - mn); ls += p; st[kt][qt][jj] = p; }
            lrun[qt] = ls;
        }
#pragma unroll
        for (int kp = 0; kp < 2; ++kp) {
            bf16x8 bp[2];
#pragma unroll
            for (int qt = 0; qt < 2; ++qt) {
                u32x4 pw; pw.x = pk2(st[2 * kp][qt][0], st[2 * kp][qt][1]); pw.y = pk2(st[2 * kp][qt][2], st[2 * kp][qt][3]);
                pw.z = pk2(st[2 * kp + 1][qt][0], st[2 * kp + 1][qt][1]); pw.w = pk2(st[2 * kp + 1][qt][2], st[2 * kp + 1][qt][3]);
                bp[qt] = __builtin_bit_cast(bf16x8, pw);
            }
#pragma unroll
            for (int dt = 0; dt < 4; ++dt) {
                const u32x2 v0 = *(const LAS u32x2*)(sVT + (16 * dt + r) * 72 + 32 * kp + 4 * q), v1 = *(const LAS u32x2*)(sVT + (16 * dt + r) * 72 + 32 * kp + 16 + 4 * q);
                u32x4 vw; vw.x = v0.x; vw.y = v0.y; vw.z = v1.x; vw.w = v1.y;
                const bf16x8 av = __builtin_bit_cast(bf16x8, vw);
                o[dt][0] = mma(av, bp[0], o[dt][0]); o[dt][1] = mma(av, bp[1], o[dt][1]);
            }
        }
    }
#pragma unroll
    for (int qt = 0; qt < 2; ++qt) {
        float lt = lrun[qt]; lt += shx(lt, 16, F.lane); lt += shx(lt, 32, F.lane);
        const float inv = __builtin_amdgcn_rcpf(lt);
        bf16* op = F.OB + (size_t)(row0 + qoff + 16 * qt + r) * 1024 + hq * 64 + 4 * q;
#pragma unroll
        for (int dt = 0; dt < 4; ++dt) { const f32x4 v = o[dt][qt] * inv; u32x2 ow; ow.x = pk2(v[0], v[1]); ow.y = pk2(v[2], v[3]); *(u32x2*)(op + 16 * dt) = ow; }
    }
    __syncthreads();
}


#define CAS __attribute__((address_space(4)))
__device__ __forceinline__ const float* ld_in(const CAS unsigned char* kargp, int k) { asm volatile("" : "+s"(k)); return *(const float* const CAS*)(kargp + (size_t)k * 8); }
__device__ __forceinline__ unsigned char* ws_at(unsigned char* ws, unsigned long long off) { asm volatile("" : "+s"(off)); return ws + off; }
__device__ __forceinline__ void fill_ptrs(Fr& F, const CAS unsigned char* kargp) {
    F.x = ld_in(kargp, 0); F.c = ld_in(kargp, 1); F.ctx = ld_in(kargp, 2); F.c_ctx = ld_in(kargp, 3); F.ada_w = ld_in(kargp, 4); F.ada_b = ld_in(kargp, 5); F.norm_g = ld_in(kargp, 6); F.final_g = ld_in(kargp, 7);
    F.ffn_w_in = ld_in(kargp, 8); F.ffn_w_out = ld_in(kargp, 9); F.gla_w_in = ld_in(kargp, 10); F.gla_w_a2 = ld_in(kargp, 11); F.gla_b_a = ld_in(kargp, 12); F.gla_norm_g = ld_in(kargp, 13); F.gla_w_out = ld_in(kargp, 14);
    F.rg_w_in = ld_in(kargp, 15); F.rg_conv_w = ld_in(kargp, 16); F.rg_conv_b = ld_in(kargp, 17); F.rg_w_a = ld_in(kargp, 18); F.rg_b_a = ld_in(kargp, 19); F.rg_w_x = ld_in(kargp, 20); F.rg_b_x = ld_in(kargp, 21);
    F.rg_lam = ld_in(kargp, 22); F.rg_w_out = ld_in(kargp, 23); F.swa_w_qkv = ld_in(kargp, 24); F.swa_sink = ld_in(kargp, 25); F.swa_w_out = ld_in(kargp, 26);
    F.out = (float*)ld_in(kargp, 27); unsigned char* ws = (unsigned char*)ld_in(kargp, 28); F.ws = ws;
    F.MOD = (float*)ws_at(ws, WS_MOD); F.ROPE = (float*)ws_at(ws, WS_ROPE); F.X = (float*)ws_at(ws, WS_X);
    F.WFI = (bf16*)ws_at(ws, WS_WFI); F.WFO = (bf16*)ws_at(ws, WS_WFO); F.WGI = (bf16*)ws_at(ws, WS_WGI); F.WGO = (bf16*)ws_at(ws, WS_WGO); F.WRI = (bf16*)ws_at(ws, WS_WRI); F.WRO = (bf16*)ws_at(ws, WS_WRO);
    F.WRA = (bf16*)ws_at(ws, WS_WRA); F.WRX = (bf16*)ws_at(ws, WS_WRX); F.WSQ = (bf16*)ws_at(ws, WS_WSQ); F.WSO = (bf16*)ws_at(ws, WS_WSO);
    F.XN = (bf16*)ws_at(ws, WS_XN); F.OB = (bf16*)ws_at(ws, WS_OB); F.H = (bf16*)ws_at(ws, WS_AR + A_H);
    F.P = (bf16*)ws_at(ws, WS_AR + A_P); F.LR = (float*)ws_at(ws, WS_AR + A_LR); F.QD = (bf16*)ws_at(ws, WS_AR + A_QD); F.KN = (bf16*)ws_at(ws, WS_AR + A_KN); F.DEC = (float*)ws_at(ws, WS_AR + A_DEC); F.US = (bf16*)ws_at(ws, WS_AR + A_US);
    F.GG = (bf16*)ws_at(ws, WS_AR + A_GG); F.XR = (bf16*)ws_at(ws, WS_AR + A_XR); F.AP = (float*)ws_at(ws, WS_AR + A_AP); F.HE = (float*)ws_at(ws, WS_AR + A_HE); F.CIN = (float*)ws_at(ws, WS_AR + A_CIN); F.LAg = (bf16*)ws_at(ws, WS_AR + A_LA); F.UUg = (bf16*)ws_at(ws, WS_AR + A_UU);
    F.QKV = (bf16*)ws_at(ws, WS_AR + A_QKV); F.SLAB = (float*)ws_at(ws, WS_SLAB);
}

#ifdef DBG_CHECK
__device__ __forceinline__ bool bad16(unsigned short u) { return (u & 0x7f80u) == 0x7f80u; }
__device__ __forceinline__ bool bad32(unsigned u) { return (u & 0x7f800000u) == 0x7f800000u; }
__device__ __forceinline__ void dbg_scan(const Fr& F, unsigned* flag) {
    const size_t gt = (size_t)F.bx * 512 + F.tid, NGT = (size_t)F.G * 512;
    unsigned m = 0;
    for (size_t i = gt; i < (size_t)MT * 32; i += NGT) if (bad32(((const unsigned*)F.LR)[i])) m |= 1u;
    for (size_t i = gt; i < (size_t)MT * 3072; i += NGT) if (bad16(F.P[i])) m |= 2u;
    for (size_t i = gt; i < (size_t)2 * MT * 512; i += NGT) { if (bad16(F.QD[i])) m |= 4u; if (bad16(F.KN[i])) m |= 8u; }
    for (size_t i = gt; i < (size_t)2 * NCH * 4 * 32768; i += NGT) if (bad16(F.US[i])) m |= 16u;
    for (size_t i = gt; i < (size_t)MT * 1024; i += NGT) if (bad16(F.OB[i])) m |= 32u;
    if (m) atomicOr(flag, m);
}
#endif

#define XB_TMO      128
#define XB_XCNT(j)  (256  + 64 * (j))
#define XB_XSUB(j)  (1280 + 64 * (j))
#define XB_XGEN(j)  (2304 + 64 * (j))
#define XB_TOP      3328
#define XB_TOPGEN   3392
#define XCD_BAR_WORDS 3456
#define XB_SPIN_CAP (1u << 18)

__device__ __forceinline__ unsigned xb_ld(unsigned* p)              { return __hip_atomic_load(p, __ATOMIC_RELAXED, __HIP_MEMORY_SCOPE_AGENT); }
__device__ __forceinline__ unsigned xb_add(unsigned* p, unsigned v) { return __hip_atomic_fetch_add(p, v, __ATOMIC_RELAXED, __HIP_MEMORY_SCOPE_AGENT); }
__device__ __forceinline__ unsigned xb_xcc_id() { return (unsigned)__builtin_amdgcn_s_getreg((3 << 11) | 20) & 0xFu; }
#define XB_SPIN(cond, bar) do { unsigned _sp = 0; while (cond) { __builtin_amdgcn_s_sleep(1); \
    if ((++_sp & 255u) == 0u) { if (xb_ld(&(bar)[XB_TMO])) break; if (_sp > XB_SPIN_CAP) { atomicAdd(&(bar)[XB_TMO], 1u); break; } } } } while (0)

struct XcdBarrier {
    unsigned* bar; unsigned x;
    volatile LAS unsigned* st;
};

__device__ __forceinline__ XcdBarrier xcd_barrier_post(unsigned* bar, volatile LAS unsigned* st) {
    XcdBarrier b; b.bar = bar; b.x = xb_xcc_id(); b.st = st;
    if (threadIdx.x == 0) (void)xb_add(&bar[XB_XCNT(b.x)], 1u);
    return b;
}
__device__ __forceinline__ void xcd_barrier_complete(unsigned* bar, unsigned x, unsigned& nloc, unsigned& nx) {
    const unsigned G = gridDim.x * gridDim.y * gridDim.z;
    unsigned sum, cnt, mine, sp = 0u;
    for (;;) {
        sum = 0u; cnt = 0u; mine = 0u;
#pragma unroll
        for (unsigned j = 0; j < 16; ++j) { const unsigned c = xb_ld(&bar[XB_XCNT(j)]); sum += c; cnt += (c > 0u) ? 1u : 0u; mine = (j == x) ? c : mine; }
        if (sum == G) break;
        __builtin_amdgcn_s_sleep(1);
        if ((++sp & 255u) == 0u) { if (xb_ld(&bar[XB_TMO])) break; if (sp > XB_SPIN_CAP) { atomicAdd(&bar[XB_TMO], 1u); break; } }
    }
    nloc = mine > 0u ? mine : 1u; nx = cnt > 0u ? cnt : 1u;
}

__device__ __forceinline__ void xcd_barrier(const XcdBarrier& b) {
    asm volatile("s_waitcnt vmcnt(0)" ::: "memory");
    __syncthreads();
    if (threadIdx.x == 0) {
        unsigned* bar = b.bar;
        __builtin_amdgcn_s_waitcnt(0);
        unsigned nloc = b.st[0], nx = b.st[1];
        if (nloc == 0u) { xcd_barrier_complete(bar, b.x, nloc, nx); b.st[0] = nloc; b.st[1] = nx; }
        const unsigned old = xb_add(&bar[XB_XSUB(b.x)], 1u);
        const unsigned gen = old / nloc;
        if (old + 1u == (gen + 1u) * nloc) {
            __builtin_amdgcn_fence(__ATOMIC_RELEASE, "agent");
            asm volatile("s_waitcnt vmcnt(0)" ::: "memory");
            const unsigned og = xb_add(&bar[XB_TOP], 1u);
            const unsigned tg = og / nx;
            if (og + 1u == (tg + 1u) * nx) xb_add(&bar[XB_TOPGEN], 1u);
            else XB_SPIN(xb_ld(&bar[XB_TOPGEN]) == tg, bar);
            __builtin_amdgcn_fence(__ATOMIC_ACQUIRE, "agent");
            xb_add(&bar[XB_XGEN(b.x)], 1u);
            asm volatile("s_waitcnt vmcnt(0)" ::: "memory");
        } else {
            XB_SPIN(xb_ld(&bar[XB_XGEN(b.x)]) == gen, bar);
            __builtin_amdgcn_fence(__ATOMIC_ACQUIRE, "agent");
            asm volatile("s_waitcnt vmcnt(0)" ::: "memory");
        }
    }
    __syncthreads();
}


__global__ void __launch_bounds__(512) fwd_megakernel(Args args) {
    extern __shared__ __attribute__((aligned(16))) unsigned char lds_raw[];
    cg::grid_group grid = cg::this_grid();
    Fr B0;
    B0.lds = (LAS unsigned char*)lds_raw; B0.tid = 0; B0.lane = 0; B0.wave = __builtin_amdgcn_readfirstlane(threadIdx.x >> 6); B0.G = gridDim.x; B0.bx = blockIdx.x;
    const CAS unsigned char* kargp = (const CAS unsigned char*)__builtin_amdgcn_kernarg_segment_ptr();
    if (threadIdx.x < 16) ((LAS unsigned*)(B0.lds + LDS_MISC))[threadIdx.x] = 0u;
    __syncthreads();
    const XcdBarrier bar = xcd_barrier_post((unsigned*)(args.ws + WS_BAR), (volatile LAS unsigned*)(B0.lds + LDS_MISC));
    const int lo = args.ph_lo, hi = args.ph_hi;
    if (hi < 0) grid.sync();
    int ph = 0;
#define PH_BEGIN_G(g) if (ph >= lo && ph < hi) for (int rep_ = 0; rep_ < (int)((DUP_MASK >> (g)) & 1) + 1; ++rep_) { Fr F = B0; { unsigned m1_ = ~0u; asm volatile("" : "+s"(m1_)); F.lane = (int)__builtin_amdgcn_mbcnt_hi(m1_, __builtin_amdgcn_mbcnt_lo(m1_, 0u)); } asm volatile("" : "+s"(F.G)); asm volatile("" : "+s"(F.bx)); asm volatile("" : "+s"(F.wave)); F.tid = F.wave * 64 + F.lane; fill_ptrs(F, kargp);
#define PH_END xcd_barrier(bar); } ++ph;

    PH_BEGIN_G(0)
#ifndef NO_PRO
 ph_prologue(F);
#endif
 PH_END

#pragma unroll 1
    for (int layer = 0; layer < DEPTH; ++layer) {
        const int mix = layer % 3, j = layer / 3; const bool last = (layer == DEPTH - 1);
        PH_BEGIN_G(1) ph_norm(F, layer, 0, MT, layer == 0 ? 0 : DFF / 256); PH_END
        PH_BEGIN_G(2) { EpiSwiglu E{F.H}; run_gemm(F, F.XN, F.WFI + (size_t)(layer * 2 + 0) * 2 * DFF * D, MT, 2 * DFF, D, E); } PH_END
        PH_BEGIN_G(3) run_resid_gemm(F, F.H, F.WFO + (size_t)(layer * 2 + 0) * D * DFF, DFF, true, F.MOD + (size_t)layer * 2 * NMODV, 2, rep_ == (int)((DUP_MASK >> 3) & 1) ? 0.5f : 0.0f); PH_END
        PH_BEGIN_G(1) ph_norm(F, layer, 1, MT, DFF / 256); PH_END
        const int Mact = last ? SEQ : MT;
        if (mix == 0) {
            PH_BEGIN_G(4) { EpiGlaIn E{F.P, F.LR}; run_gemm(F, F.XN, F.WGI + (size_t)j * GLA_NP * D, MT, GLA_NP, D, E); } PH_END
            PH_BEGIN_G(6)
#ifndef NO_GLAB
 for (int u = F.bx; u < NCH * 8; u += F.G) gla_b_unit(F, j, u >> 3, (u >> 1) & 3, u & 1);
#endif
 PH_END
            PH_BEGIN_G(31)
#ifndef NO_GLAC
 gla_scan(F);
#endif
 PH_END
            PH_BEGIN_G(7)
#ifndef NO_GLAD
 { const int nu = (last ? 256 : NCH) * 4; for (int u = F.bx; u < nu; u += F.G) gla_d_unit(F, j, u >> 2, u & 3); }
#endif
 PH_END
            PH_BEGIN_G(5) run_resid_gemm(F, F.OB, F.WGO + (size_t)j * D * D, D, !last, F.MOD + (size_t)layer * 2 * NMODV, 5, rep_ == (int)((DUP_MASK >> 5) & 1) ? 1.0f : 0.0f); PH_END
        } else if (mix == 1) {
            PH_BEGIN_G(4) { EpiRgIn E{F.GG, F.XR}; run_gemm(F, F.XN, F.WRI, MT, 3072, D, E); } PH_END
            PH_BEGIN_G(8)
#ifndef NO_RG
 { int it_ = 0; for (int u = F.bx; u < NCH * 12; u += F.G, ++it_) rg_unit(F, u / 12, u % 12, 0, it_ & 1); __syncthreads(); }
#endif
 PH_END
            PH_BEGIN_G(9) rg_carry(F); PH_END
            PH_BEGIN_G(11)
#ifndef NO_RG
 for (int u = F.bx; u < NCH * 12; u += F.G) rg_unit1(F, u / 12, u % 12);
#endif
 PH_END
            PH_BEGIN_G(5) run_resid_gemm(F, F.OB, F.WRO, 1536, !last, F.MOD + (size_t)layer * 2 * NMODV, 5, rep_ == (int)((DUP_MASK >> 5) & 1) ? 1.0f : 0.0f); PH_END
        } else {
            PH_BEGIN_G(4) { EpiSwaQkv E{F.QKV, F.ROPE}; run_gemm(F, F.XN, F.WSQ, MT, 1536, D, E); } PH_END
            PH_BEGIN_G(10)
#ifndef NO_SWA
 for (int u = F.bx; u < NCH * 4; u += F.G) swa_unit(F, u >> 2, u & 3);
#endif
 PH_END
            PH_BEGIN_G(5) run_resid_gemm(F, F.OB, F.WSO, D, !last, F.MOD + (size_t)layer * 2 * NMODV, 5, rep_ == (int)((DUP_MASK >> 5) & 1) ? 1.0f : 0.0f); PH_END
        }
        PH_BEGIN_G(1) ph_norm(F, layer, 2, Mact, mix == 1 ? 1536 / 256 : D / 256); PH_END
        PH_BEGIN_G(2) { EpiSwiglu E{F.H}; run_gemm(F, F.XN, F.WFI + (size_t)(layer * 2 + 1) * 2 * DFF * D, Mact, 2 * DFF, D, E); } PH_END
        PH_BEGIN_G(3) run_resid_gemm(F, F.H, F.WFO + (size_t)(layer * 2 + 1) * D * DFF, DFF, !last, F.MOD + (size_t)layer * 2 * NMODV, 8, rep_ == (int)((DUP_MASK >> 3) & 1) ? 0.5f : 0.0f); PH_END
    }
#ifdef DBG_CHECK
    { Fr F = B0; { unsigned m1_ = ~0u; asm volatile("" : "+s"(m1_)); F.lane = (int)__builtin_amdgcn_mbcnt_hi(m1_, __builtin_amdgcn_mbcnt_lo(m1_, 0u)); } asm volatile("" : "+s"(F.G)); asm volatile("" : "+s"(F.bx)); asm volatile("" : "+s"(F.wave)); F.tid = F.wave * 64 + F.lane; fill_ptrs(F, kargp);
      unsigned* flag = (unsigned*)(F.ws + 512 * 1024);
      dbg_scan(F, flag);
      for (size_t i = (size_t)F.bx * 512 + F.tid; i < (size_t)SEQ * D; i += (size_t)F.G * 512) F.out[i] = 0.f;
      xcd_barrier(bar);
      if (F.bx == 0 && F.tid == 0) F.out[0] = 1000.0f * (float)(__hip_atomic_load(flag, __ATOMIC_RELAXED, __HIP_MEMORY_SCOPE_AGENT) + 1u);
    }
#else
    { Fr F = B0; { unsigned m1_ = ~0u; asm volatile("" : "+s"(m1_)); F.lane = (int)__builtin_amdgcn_mbcnt_hi(m1_, __builtin_amdgcn_mbcnt_lo(m1_, 0u)); } asm volatile("" : "+s"(F.G)); asm volatile("" : "+s"(F.bx)); asm volatile("" : "+s"(F.wave)); F.tid = F.wave * 64 + F.lane; fill_ptrs(F, kargp); ph_final(F); }
#endif
}

extern "C" void kernel_launch(void* const* d_in, const int* in_sizes, int n_in, void* d_out, int out_size, void* d_ws, size_t ws_size, hipStream_t stream) {
    static int grid = 0;
    if (grid == 0) {
        if (n_in != 27 || out_size != SEQ * D || ws_size < WS_END) { fprintf(stderr, "kernel_launch: unexpected shapes (n_in %d out %d ws %zu)\n", n_in, out_size, ws_size); grid = -1; return; }
        int dev = 0, cus = 0, per_cu = 0;
        hipGetDevice(&dev);
        hipDeviceGetAttribute(&cus, hipDeviceAttributeMultiprocessorCount, dev);
        hipFuncSetAttribute((const void*)fwd_megakernel, hipFuncAttributeMaxDynamicSharedMemorySize, LDS_BYTES);
        hipOccupancyMaxActiveBlocksPerMultiprocessor(&per_cu, (const void*)fwd_megakernel, 512, LDS_BYTES);
        if (per_cu < 1) { fprintf(stderr, "kernel_launch: occupancy query says %d blocks per CU\n", per_cu); per_cu = 1; }
        (void)hipGetLastError();
        grid = cus * 1;
        fprintf(stderr, "kernel_launch: grid %d (cus %d, per_cu %d)\n", grid, cus, per_cu);
    }
    if (grid < 0) return;
    if (hipMemsetAsync((char*)d_ws + WS_BAR, 0, BAR_BYTES, stream) != hipSuccess) { fprintf(stderr, "kernel_launch: memset failed\n"); return; }
    Args a{};
    for (int i = 0; i < 27; ++i) a.in[i] = (const float*)d_in[i];
    a.out = (float*)d_out; a.ws = (unsigned char*)d_ws; a.ph_lo = 0; a.ph_hi = PH_LIMIT;
    void* kargs[] = {&a};
    hipError_t e = hipLaunchCooperativeKernel((const void*)fwd_megakernel, dim3(grid), dim3(512), kargs, LDS_BYTES, stream);
    if (e != hipSuccess) fprintf(stderr, "cooperative launch failed: %s (grid %d)\n", hipGetErrorString(e), grid);
}
```
